# Optimizing an MI355X kernel written in HIP

```python
import jax, jax.numpy as jnp
from jax import lax
import numpy as np

D_MODEL = 2048
BATCH = 2
SEQ = 4096
DEPTH = 1

GRID_W = 64
CTX_LEN = 256
D_GLA = 1024
D_CONV = 1024
GLA_HEADS = 4
GLA_DK = 128
GLA_DV = 256
GLA_KEY = GLA_HEADS * GLA_DK
GATE_RANK = 16
GATE_NORMALIZER = 16.0
CHUNK = 64
CONV_WIDTH = 31
D_FF = 5632
N_MOD = 9
RMS_EPS = 1e-6
HEAD_NORM_EPS = 1e-5
LN_EPS = 1e-5

P_K = GLA_KEY
P_V = D_GLA
P_Q = GLA_KEY
P_G = D_GLA
P_GLU = 2 * D_CONV
OFF_V = P_K
OFF_GKF = OFF_V + P_V
OFF_GKB = OFF_GKF + GATE_RANK
CTX_COLS = OFF_GKB + GATE_RANK
OFF_Q = CTX_COLS
OFF_G = OFF_Q + P_Q
OFF_GLU = OFF_G + P_G
D_IN = OFF_GLU + P_GLU

kernel_name = "hybrid_gla_conformer_dit_block"


def rmsnorm(h, gain, eps=RMS_EPS):
    hf = h.astype(jnp.float32)
    hf = hf * lax.rsqrt(jnp.mean(hf * hf, axis=-1, keepdims=True) + eps)
    return (hf * gain.astype(jnp.float32)).astype(h.dtype)


def modulate(h, gain, shift, scale):
    return rmsnorm(h, gain) * (1 + scale) + shift


def swiglu(h, w_in, w_out):
    gate, up = jnp.split(h @ w_in, 2, axis=-1)
    return (jax.nn.silu(gate) * up) @ w_out


def heads(t, d):
    b, t_len, _ = t.shape
    return t.reshape(b, t_len, -1, d).transpose(0, 2, 1, 3)


def flip(t):
    return jnp.flip(t, axis=2)


def log_decay(p_gk, w2, b2):
    z = (p_gk.astype(jnp.float32) @ w2.astype(jnp.float32)) + b2.astype(jnp.float32)
    return jax.nn.log_sigmoid(z) / GATE_NORMALIZER


def gla_final_state(k, v, logd):
    b = jnp.cumsum(logd, axis=2)
    k_dec = k * jnp.exp(b[:, :, -1:] - b)
    return jnp.einsum('bhld,bhle->bhde', k_dec, v)


def gla_chunked(q, k, v, logd, s0):
    bsz, nh, t_len, dk = q.shape
    dv = v.shape[-1]
    n = t_len // CHUNK
    q = q.reshape(bsz, nh, n, CHUNK, dk)
    k = k.reshape(bsz, nh, n, CHUNK, dk)
    v = v.reshape(bsz, nh, n, CHUNK, dv)
    b = jnp.cumsum(logd.reshape(bsz, nh, n, CHUNK, dk), axis=3)
    b_mid = b[:, :, :, CHUNK // 2 - 1:CHUNK // 2]
    b_last = b[:, :, :, -1:]
    qs = q * jnp.exp(b - b_mid)
    ks = k * jnp.exp(b_mid - b)
    mask = jnp.tril(jnp.ones((CHUNK, CHUNK), dtype=bool))
    att = jnp.where(mask, jnp.einsum('bhncd,bhnsd->bhncs', qs, ks), 0.0)
    o = jnp.einsum('bhncs,bhnse->bhnce', att, v)
    chunk_kv = jnp.einsum('bhncd,bhnce->bhnde', k * jnp.exp(b_last - b), v)
    chunk_decay = jnp.exp(b_last[:, :, :, 0])

    def step(s, inp):
        dec, kv = inp
        return dec[..., None] * s + kv, s

    _, s_in = lax.scan(step, s0, (jnp.moveaxis(chunk_decay, 2, 0), jnp.moveaxis(chunk_kv, 2, 0)))
    s_in = jnp.moveaxis(s_in, 0, 2)
    o = o + jnp.einsum('bhncd,bhnde->bhnce', q * jnp.exp(b), s_in)
    return o.reshape(bsz, nh, t_len, dv)


def gla_inputs_kv(p, w_gk2, b_gk2):
    f32 = jnp.float32
    k = heads(p[..., :OFF_V].astype(f32), GLA_DK)
    v = heads(p[..., OFF_V:OFF_GKF].astype(f32), GLA_DV)
    ld_f = heads(log_decay(p[..., OFF_GKF:OFF_GKB], w_gk2[0], b_gk2[0]), GLA_DK)
    ld_b = heads(log_decay(p[..., OFF_GKB:CTX_COLS], w_gk2[1], b_gk2[1]), GLA_DK)
    return k, v, ld_f, ld_b


def context_states(pc, w_gk2, b_gk2):
    k, v, ld_f, ld_b = gla_inputs_kv(pc, w_gk2, b_gk2)
    return gla_final_state(k, v, ld_f), gla_final_state(flip(k), flip(v), flip(ld_b))


def gla_group(p, w_gk2, b_gk2, norm_g, s_f, s_b):
    k, v, ld_f, ld_b = gla_inputs_kv(p, w_gk2, b_gk2)
    q = heads(p[..., OFF_Q:OFF_G].astype(jnp.float32), GLA_DK) * (GLA_DK ** -0.5)
    g = p[..., OFF_G:OFF_GLU]
    o = gla_chunked(q, k, v, ld_f, s_f) + flip(gla_chunked(flip(q), flip(k), flip(v), flip(ld_b), s_b))
    o = o * lax.rsqrt(jnp.mean(o * o, axis=-1, keepdims=True) + HEAD_NORM_EPS) * norm_g.astype(jnp.float32)
    bsz, _, t_len, _ = o.shape
    o = o.transpose(0, 2, 1, 3).reshape(bsz, t_len, D_GLA).astype(p.dtype)
    return o * jax.nn.silu(g)


def conv_latent(u, w, b):
    bsz, t_len, ch = u.shape
    rows = t_len // GRID_W
    half = ch // 2
    grid = u.reshape(bsz, rows, GRID_W, ch)
    dn = ('NHWC', 'HWIO', 'NHWC')
    row_part = lax.conv_general_dilated(grid[..., :half], w[:, :half].reshape(1, CONV_WIDTH, 1, half).astype(u.dtype),
                                        (1, 1), 'SAME', dimension_numbers=dn, feature_group_count=half)
    col_part = lax.conv_general_dilated(grid[..., half:], w[:, half:].reshape(CONV_WIDTH, 1, 1, half).astype(u.dtype),
                                        (1, 1), 'SAME', dimension_numbers=dn, feature_group_count=half)
    return jnp.concatenate([row_part, col_part], axis=-1).reshape(bsz, t_len, ch) + b


def conv_seq(u, w, b):
    ch = u.shape[-1]
    y = lax.conv_general_dilated(u, w.reshape(CONV_WIDTH, 1, ch).astype(u.dtype), (1,), 'SAME',
                                 dimension_numbers=('NWC', 'WIO', 'NWC'), feature_group_count=ch)
    return y + b


def conformer_group(p_glu, conv_fn, conv_w, conv_b, ln_g, ln_b):
    a, gate = jnp.split(p_glu, 2, axis=-1)
    y = conv_fn(a * jax.nn.sigmoid(gate), conv_w, conv_b)
    yf = y.astype(jnp.float32)
    mu = jnp.mean(yf, axis=-1, keepdims=True)
    var = jnp.mean(jnp.square(yf - mu), axis=-1, keepdims=True)
    yf = (yf - mu) * lax.rsqrt(var + LN_EPS) * ln_g.astype(jnp.float32) + ln_b.astype(jnp.float32)
    return jax.nn.silu(yf).astype(p_glu.dtype)


def setup_inputs(seed: int = 0) -> dict:
    key = jax.random.key(seed)
    ks = jax.random.split(key, 26)
    f32 = jnp.float32

    def nrm(k, shape, scale):
        return jax.random.normal(k, shape, f32) * scale

    def gain(k, shape):
        return 1.0 + 0.02 * jax.random.normal(k, shape, f32)

    d = D_MODEL
    return {
        "x": nrm(ks[0], (BATCH, SEQ, d), 1.0),
        "c": nrm(ks[1], (BATCH, d), 1.0),
        "ctx": nrm(ks[2], (BATCH, CTX_LEN, d), 1.0),
        "c_ctx": nrm(ks[3], (d,), 1.0),
        "w_mod": nrm(ks[4], (DEPTH, d, N_MOD * d), 0.5 * d ** -0.5),
        "b_mod": nrm(ks[5], (DEPTH, N_MOD * d), 0.01),
        "norm_ffn1": gain(ks[6], (DEPTH, d)),
        "w_ffn1_in": nrm(ks[7], (DEPTH, d, 2 * D_FF), d ** -0.5),
        "w_ffn1_out": nrm(ks[8], (DEPTH, D_FF, d), D_FF ** -0.5),
        "norm_mix": gain(ks[9], (DEPTH, d)),
        "w_in": nrm(ks[10], (DEPTH, d, D_IN), d ** -0.5),
        "w_gk2": nrm(ks[11], (DEPTH, 2, GATE_RANK, GLA_KEY), GATE_RANK ** -0.5),
        "b_gk2": nrm(ks[12], (DEPTH, 2, GLA_KEY), 0.5),
        "gla_norm": gain(ks[13], (DEPTH, GLA_DV)),
        "conv_w": nrm(ks[14], (DEPTH, CONV_WIDTH, D_CONV), CONV_WIDTH ** -0.5),
        "conv_b": nrm(ks[15], (DEPTH, D_CONV), 0.01),
        "conv_ln_g": gain(ks[16], (DEPTH, D_CONV)),
        "conv_ln_b": nrm(ks[17], (DEPTH, D_CONV), 0.01),
        "w_out": nrm(ks[18], (DEPTH, D_GLA + D_CONV, d), (D_GLA + D_CONV) ** -0.5),
        "norm_ffn2": gain(ks[19], (DEPTH, d)),
        "w_ffn2_in": nrm(ks[20], (DEPTH, d, 2 * D_FF), d ** -0.5),
        "w_ffn2_out": nrm(ks[21], (DEPTH, D_FF, d), D_FF ** -0.5),
        "norm_final": gain(ks[22], (d,)),
    }


def reference(x, c, ctx, c_ctx, w_mod, b_mod, norm_ffn1, w_ffn1_in, w_ffn1_out, norm_mix, w_in,
              w_gk2, b_gk2, gla_norm, conv_w, conv_b, conv_ln_g, conv_ln_b, w_out, norm_ffn2,
              w_ffn2_in, w_ffn2_out, norm_final):
    bsz = x.shape[0]
    h = x
    hc = ctx
    for l in range(DEPTH):
        mod = (jax.nn.silu(c) @ w_mod[l] + b_mod[l]).reshape(bsz, N_MOD, D_MODEL)[:, :, None, :]
        mc = (jax.nn.silu(c_ctx) @ w_mod[l] + b_mod[l]).reshape(N_MOD, D_MODEL)

        h = h + 0.5 * mod[:, 2] * swiglu(modulate(h, norm_ffn1[l], mod[:, 0], mod[:, 1]), w_ffn1_in[l], w_ffn1_out[l])
        hc = hc + 0.5 * mc[2] * swiglu(modulate(hc, norm_ffn1[l], mc[0], mc[1]), w_ffn1_in[l], w_ffn1_out[l])

        hx = modulate(h, norm_mix[l], mod[:, 3], mod[:, 4])
        hcm = modulate(hc, norm_mix[l], mc[3], mc[4])
        px = hx @ w_in[l]
        pc_kv = hcm @ w_in[l][:, :CTX_COLS]
        s_f, s_b = context_states(pc_kv, w_gk2[l], b_gk2[l])
        o_gla = gla_group(px, w_gk2[l], b_gk2[l], gla_norm[l], s_f, s_b)
        o_conv = conformer_group(px[..., OFF_GLU:], conv_latent, conv_w[l], conv_b[l], conv_ln_g[l], conv_ln_b[l])
        h = h + mod[:, 5] * (jnp.concatenate([o_gla, o_conv], axis=-1) @ w_out[l])

        h = h + 0.5 * mod[:, 8] * swiglu(modulate(h, norm_ffn2[l], mod[:, 6], mod[:, 7]), w_ffn2_in[l], w_ffn2_out[l])

        if l + 1 < DEPTH:
            pc = hcm @ w_in[l]
            zeros = jnp.zeros((bsz, GLA_HEADS, GLA_DK, GLA_DV), jnp.float32)
            oc_gla = gla_group(pc, w_gk2[l], b_gk2[l], gla_norm[l], zeros, zeros)
            oc_conv = conformer_group(pc[..., OFF_GLU:], conv_seq, conv_w[l], conv_b[l], conv_ln_g[l], conv_ln_b[l])
            hc = hc + mc[5] * (jnp.concatenate([oc_gla, oc_conv], axis=-1) @ w_out[l])
            hc = hc + 0.5 * mc[8] * swiglu(modulate(hc, norm_ffn2[l], mc[6], mc[7]), w_ffn2_in[l], w_ffn2_out[l])
    return rmsnorm(h, norm_final)
```

```cpp
#include <hip/hip_runtime.h>
#include <hip/hip_cooperative_groups.h>
#include <cstdio>
namespace cg = cooperative_groups;

#define LAS __attribute__((address_space(3)))
typedef unsigned short bf16_t;
typedef short bf16x8 __attribute__((ext_vector_type(8)));
typedef float f32x4 __attribute__((ext_vector_type(4)));
typedef float f32x2 __attribute__((ext_vector_type(2)));
typedef unsigned u32x4 __attribute__((ext_vector_type(4)));
typedef unsigned u32x2 __attribute__((ext_vector_type(2)));

constexpr int D = 2048, TL = 8192, TCX = 512, MT = 8704, DFF = 5632, NFF = 11264, NIN = 5152, N3 = 5376, PXW = 3072, NMOD = 18432;
constexpr int NSLOT = 68;
constexpr int LDS_BYTES = 147456;
constexpr int NPHASE = 14;
#ifndef PH_MASK
#define PH_MASK 0x3fff
#endif
#define PH_ON(n) (((PH_MASK) >> (n)) & 1)
#ifndef REP_MASK
#define REP_MASK 0
#endif
#ifndef DBG_ZERO_GLA
#define DBG_ZERO_GLA 0
#endif
#ifndef DBG_ZERO_CONV
#define DBG_ZERO_CONV 0
#endif

constexpr size_t al256(size_t x) { return (x + 255) & ~(size_t)255; }
constexpr size_t WS_WT1 = 0;
constexpr size_t WS_WT2 = WS_WT1 + al256((size_t)NFF * D * 2);
constexpr size_t WS_WT3 = WS_WT2 + al256((size_t)D * DFF * 2);
constexpr size_t WS_WT4 = WS_WT3 + al256((size_t)N3 * D * 2);
constexpr size_t WS_WT5 = WS_WT4 + al256((size_t)D * D * 2);
constexpr size_t WS_WT6 = WS_WT5 + al256((size_t)NFF * D * 2);
constexpr size_t WS_MOD = WS_WT6 + al256((size_t)D * DFF * 2);
constexpr size_t WS_ACT = WS_MOD + al256((size_t)3 * NMOD * 4);
constexpr size_t WS_HID = WS_ACT + al256((size_t)MT * D * 2);
constexpr size_t WS_H1 = WS_HID + al256((size_t)MT * DFF * 2);
constexpr size_t WS_PX = WS_H1 + al256((size_t)MT * D * 4);
constexpr size_t WS_U = WS_PX + al256((size_t)MT * PXW * 2);
constexpr size_t WS_GK = WS_U + al256((size_t)TL * 1024 * 2);
constexpr size_t WS_DEC = WS_GK + al256((size_t)MT * 32 * 4);
constexpr size_t WS_PART = WS_DEC + al256((size_t)2 * 8 * NSLOT * 128 * 4);
constexpr size_t WS_BAR = WS_PART + al256((size_t)11 * TCX * D * 4);
constexpr size_t WS_CNT = WS_BAR + 16384;
constexpr size_t WS_XB = WS_CNT + 3 * 32 * 256;
constexpr size_t WS_BC = WS_XB + al256((size_t)TL * 8 * 4);
constexpr size_t WS_VT = WS_BC + (size_t)2 * 8 * 64 * 64 * 128 * 4;
constexpr size_t WS_END = WS_VT + (size_t)8 * 64 * 256 * 64 * 2;
constexpr size_t WS_ZERO_BYTES = 16384 + 3 * 32 * 256;

struct Params {
    const float* x; const float* c; const float* ctx; const float* c_ctx; const float* w_mod; const float* b_mod;
    const float* norm_ffn1; const float* w_ffn1_in; const float* w_ffn1_out; const float* norm_mix; const float* w_in;
    const float* w_gk2; const float* b_gk2; const float* gla_norm; const float* conv_w; const float* conv_b;
    const float* conv_ln_g; const float* conv_ln_b; const float* w_out; const float* norm_ffn2; const float* w_ffn2_in;
    const float* w_ffn2_out; const float* norm_final;
    float* out; unsigned char* ws;
};

typedef __bf16 bf16x2_t __attribute__((ext_vector_type(2)));
__device__ __forceinline__ unsigned cvt_pk_bf16(float lo, float hi) { f32x2 f = {lo, hi}; bf16x2_t v = __builtin_convertvector(f, bf16x2_t); return __builtin_bit_cast(unsigned, v); }
__device__ __forceinline__ float bf_lo(unsigned u) { return __uint_as_float(u << 16); }
__device__ __forceinline__ float bf_hi(unsigned u) { return __uint_as_float(u & 0xffff0000u); }
__device__ __forceinline__ float wave_sum(float v) {
#pragma unroll
    for (int o = 32; o >= 1; o >>= 1) v += __shfl_xor(v, o, 64);
    return v;
}
__device__ __forceinline__ float silu_f(float x) { return x * __builtin_amdgcn_rcpf(1.f + __expf(-x)); }
__device__ __forceinline__ float sigmoid_f(float x) { return __builtin_amdgcn_rcpf(1.f + __expf(-x)); }
__device__ __forceinline__ int otid() { int t = threadIdx.x; asm volatile("" : "+v"(t)); return t; }
__host__ __device__ __forceinline__ int perm32(int rho) { const int n = rho >> 4, i = rho & 15; return 8 * (i >> 2) + 4 * n + (i & 3); }

constexpr int BM = 256, BK = 64, HALF = 128, HTB = HALF * BK * 2, NXCD = 8, WGM = 4;
__device__ __forceinline__ int lds_byte(int r, int c) { const int st = (r >> 4) * 2 + (c >> 5), rr = r & 15, cc = c & 31, ob = rr * 64 + cc * 2; return st * 1024 + (ob ^ (((ob >> 9) & 1) << 5)); }
__device__ __forceinline__ void stage_rc(int b, int& R, int& C) { const int st = b / 1024, sb = b % 1024, swz = sb ^ (((sb >> 9) & 1) << 5); R = (st >> 1) * 16 + swz / 64; C = (st & 1) * 32 + (swz % 64) / 2; }

struct Unit { int pm, pn, kt0, nt; };
struct Gemm { const bf16_t* A; const bf16_t* Bt; int M, N, K; };
struct Order {
    int nM, nN, nwg, G, c, extra, mode, ntk;
    __device__ void init(int nM_, int nN_, int G_, int c_, int mode_, int ntk_) { nM = nM_; nN = nN_; nwg = nM * nN; G = G_; c = c_; mode = mode_; ntk = ntk_; extra = mode == 1 ? 14 : 0; }
    __device__ bool next(int i, Unit& u) const {
        long L = (long)i * G + c;
        u.kt0 = 0; u.nt = ntk;
        if (mode == 2) {
            const bool has_small = c < 176;
            if (has_small && i == 0) { const int idx = c; u.pm = nM + idx / 88; const int rem = idx % 88; u.pn = rem / 11; u.kt0 = (rem % 11) * 8; u.nt = 8; return true; }
            if ((has_small ? i - 1 : i) != 0) return false;
            L = c;
        }
        if (L >= nwg + extra) return false;
        if (L >= nwg) {
            const int idx = (int)L - nwg;
            if (mode == 1) { u.pm = nM + idx / 7; const int q = idx % 7; u.pn = q < 6 ? q : 20; }
            else return false;
            return true;
        }
        int wgid = (int)L; { const int q = nwg / NXCD, r = nwg % NXCD, xcd = wgid % NXCD, off = wgid / NXCD; wgid = (xcd < r ? xcd * (q + 1) : r * (q + 1) + (xcd - r) * q) + off; }
        const int nig = WGM * nN, gid = wgid / nig, fm = gid * WGM, gsz = (nM - fm) < WGM ? (nM - fm) : WGM;
        u.pm = fm + ((wgid % nig) % gsz); u.pn = (wgid % nig) / gsz; return true;
    }
};


constexpr int L_RS_P = 131072, L_RS_S = 131072 + 4096;
struct RowStats {
    unsigned* xbuf; unsigned* cnt;
    __device__ __forceinline__ void run(const f32x4 (&v)[2][2][4][2], const Unit& u, int wr, int wc, int fr, int fq, LAS unsigned char* lds, int wid, int lane) const {
        LAS float* P = (LAS float*)(lds + L_RS_P);
        LAS float* S = (LAS float*)(lds + L_RS_S);
#pragma unroll
        for (int ai = 0; ai < 2; ++ai)
#pragma unroll
            for (int m = 0; m < 4; ++m) {
                float q = 0.f;
#pragma unroll
                for (int bj = 0; bj < 2; ++bj)
#pragma unroll
                    for (int n = 0; n < 2; ++n) { const f32x4 x = v[ai][bj][m][n]; q += (x[0] * x[0] + x[1] * x[1]) + (x[2] * x[2] + x[3] * x[3]); }
                q += __shfl_xor(q, 16, 64); q += __shfl_xor(q, 32, 64);
                if (fq == 0) P[(ai * HALF + wr * 64 + m * 16 + fr) * 4 + wc] = q;
            }
        __syncthreads();
        const int row = wid * 32 + (lane & 31);
        if (lane < 32) {
            const float tot = (P[row * 4 + 0] + P[row * 4 + 1]) + (P[row * 4 + 2] + P[row * 4 + 3]);
            __hip_atomic_store(xbuf + (size_t)(u.pm * BM + row) * 8 + u.pn, __float_as_uint(tot), __ATOMIC_RELAXED, __HIP_MEMORY_SCOPE_AGENT);
        }
        asm volatile("s_waitcnt vmcnt(0)" ::: "memory");
        if (lane == 0) __hip_atomic_fetch_add(cnt + 64 * u.pm, 1u, __ATOMIC_RELAXED, __HIP_MEMORY_SCOPE_AGENT);
        if (wid == 0) {
            unsigned spins = 0;
            while ((unsigned)__builtin_amdgcn_readfirstlane(__hip_atomic_load(cnt + 64 * u.pm, __ATOMIC_RELAXED, __HIP_MEMORY_SCOPE_AGENT)) < 64u) {
                __builtin_amdgcn_s_sleep(2);
                if (++spins > (1u << 22)) break;
            }
            __builtin_amdgcn_fence(__ATOMIC_ACQUIRE, "agent");
        }
        asm volatile("s_waitcnt vmcnt(0) lgkmcnt(0)" ::: "memory");
        __syncthreads();
        if (lane < 32) {
            const unsigned* slot = xbuf + (size_t)(u.pm * BM + row) * 8; float tot = 0.f;
#pragma unroll
            for (int t = 0; t < 8; ++t) tot += __uint_as_float(__hip_atomic_load(slot + t, __ATOMIC_RELAXED, __HIP_MEMORY_SCOPE_AGENT));
            S[row] = rsqrtf(tot * (1.f / 2048.f) + 1e-6f);
        }
        __syncthreads();
    }
};

struct EpiGate {
    bf16_t* H;
    __device__ __forceinline__ bool defer(const Unit&) const { return false; }
    __device__ __forceinline__ void fused(f32x4 (&)[2][2][4][2], const Unit&, int, int, int, int, LAS unsigned char*, int, int) const {}
    __device__ __forceinline__ void operator()(const f32x4 (&acc)[2][2][4][2], const Unit& u, int wr, int wc, int fr, int fq) const {
        const int row0 = u.pm * BM + wr * 64 + fr, col0 = u.pn * 128 + wc * 32 + 8 * fq;
#pragma unroll
        for (int ai = 0; ai < 2; ++ai)
#pragma unroll
            for (int m = 0; m < 4; ++m) {
                float o[8];
#pragma unroll
                for (int n = 0; n < 2; ++n)
#pragma unroll
                    for (int i = 0; i < 4; ++i) o[n * 4 + i] = silu_f(acc[ai][0][m][n][i]) * acc[ai][1][m][n][i];
                u32x4 pk; pk[0] = cvt_pk_bf16(o[0], o[1]); pk[1] = cvt_pk_bf16(o[2], o[3]); pk[2] = cvt_pk_bf16(o[4], o[5]); pk[3] = cvt_pk_bf16(o[6], o[7]);
                *(u32x4*)(H + (size_t)(row0 + ai * HALF + m * 16) * DFF + col0) = pk;
            }
    }
};
template <int FMODE> struct EpiResid {
    const float* resid_lat; const float* resid_ctx; float* out; const float* mod; int gidx; float gs; float* part;
    RowStats st; const float* gain; int sh_idx, sc_idx; bf16_t* act; float* fout;
    __device__ __forceinline__ bool defer(const Unit& u) const { return FMODE != 0 && u.pm < TL / BM; }
    __device__ __forceinline__ void fused(f32x4 (&acc)[2][2][4][2], const Unit& u, int wr, int wc, int fr, int fq, LAS unsigned char* lds, int wid, int lane) const {
        const int rowt = u.pm * BM; const int set = rowt < 4096 ? 0 : 1;
        const float* md = mod + (size_t)set * NMOD;
        const int row0 = rowt + wr * 64 + fr, col0 = u.pn * BM + wc * 32 + 4 * fq;
        {
            f32x4 gv[2][2];
#pragma unroll
            for (int bj = 0; bj < 2; ++bj)
#pragma unroll
                for (int n = 0; n < 2; ++n) gv[bj][n] = *(const f32x4*)(md + gidx * D + col0 + bj * HALF + n * 16) * gs;
#pragma unroll
            for (int ai = 0; ai < 2; ++ai)
#pragma unroll
                for (int m = 0; m < 4; ++m) {
                    const size_t ro = (size_t)(row0 + ai * HALF + m * 16) * D + col0;
#pragma unroll
                    for (int bj = 0; bj < 2; ++bj)
#pragma unroll
                        for (int n = 0; n < 2; ++n) acc[ai][bj][m][n] = *(const f32x4*)(resid_lat + ro + bj * HALF + n * 16) + gv[bj][n] * acc[ai][bj][m][n];
                    asm volatile("" : "+v"(acc[ai][0][m][0]), "+v"(acc[ai][0][m][1]), "+v"(acc[ai][1][m][0]), "+v"(acc[ai][1][m][1]));
                    if (m & 1) asm volatile("" ::: "memory");
                }
        }
        st.run(acc, u, wr, wc, fr, fq, lds, wid, lane);
        const LAS float* S = (const LAS float*)(lds + L_RS_S);
        f32x4 g2[2][2], sh[2][2];
#pragma unroll
        for (int bj = 0; bj < 2; ++bj)
#pragma unroll
            for (int n = 0; n < 2; ++n) {
                const int c = col0 + bj * HALF + n * 16;
                g2[bj][n] = *(const f32x4*)(gain + c);
                if (FMODE == 1) { g2[bj][n] *= (*(const f32x4*)(md + sc_idx * D + c) + 1.f); sh[bj][n] = *(const f32x4*)(md + sh_idx * D + c); }
                else sh[bj][n] = (f32x4){0.f, 0.f, 0.f, 0.f};
            }
#pragma unroll
        for (int ai = 0; ai < 2; ++ai)
#pragma unroll
            for (int m = 0; m < 4; ++m) {
                const int r = ai * HALF + wr * 64 + m * 16 + fr; const float rs = S[r];
                const size_t ro = (size_t)(rowt + r) * D + col0;
#pragma unroll
                for (int bj = 0; bj < 2; ++bj)
#pragma unroll
                    for (int n = 0; n < 2; ++n) {
                        const f32x4 h = acc[ai][bj][m][n];
                        const f32x4 o = h * rs * g2[bj][n] + sh[bj][n];
                        if (FMODE == 1) {
                            *(f32x4*)(out + ro + bj * HALF + n * 16) = h;
                            u32x2 pk; pk[0] = cvt_pk_bf16(o[0], o[1]); pk[1] = cvt_pk_bf16(o[2], o[3]);
                            *(u32x2*)(act + ro + bj * HALF + n * 16) = pk;
                        } else *(f32x4*)(fout + ro + bj * HALF + n * 16) = o;
                    }
                asm volatile("" ::: "memory");
            }
    }
    __device__ __forceinline__ void operator()(const f32x4 (&acc)[2][2][4][2], const Unit& u, int wr, int wc, int fr, int fq) const {
        if (u.pm >= TL / BM) {
            float* pb = part + (size_t)(u.kt0 >> 3) * TCX * D;
            const int row0 = u.pm * BM - TL + wr * 64 + fr, col0 = u.pn * BM + wc * 32 + 4 * fq;
#pragma unroll
            for (int ai = 0; ai < 2; ++ai)
#pragma unroll
                for (int m = 0; m < 4; ++m)
#pragma unroll
                    for (int bj = 0; bj < 2; ++bj)
#pragma unroll
                        for (int n = 0; n < 2; ++n) *(f32x4*)(pb + (size_t)(row0 + ai * HALF + m * 16) * D + col0 + bj * HALF + n * 16) = acc[ai][bj][m][n];
            return;
        }
        const int rowt = u.pm * BM; const int set = rowt < 4096 ? 0 : (rowt < 8192 ? 1 : 2);
        const float* rb = rowt < TL ? resid_lat : (resid_ctx - (size_t)TL * D);
        const float* mg = mod + (size_t)set * NMOD + gidx * D;
        const int row0 = rowt + wr * 64 + fr, col0 = u.pn * BM + wc * 32 + 4 * fq;
        f32x4 gv[2][2];
#pragma unroll
        for (int bj = 0; bj < 2; ++bj)
#pragma unroll
            for (int n = 0; n < 2; ++n) gv[bj][n] = *(const f32x4*)(mg + col0 + bj * HALF + n * 16) * gs;
#pragma unroll
        for (int ai = 0; ai < 2; ++ai)
#pragma unroll
            for (int m = 0; m < 4; ++m) {
                const size_t ro = (size_t)(row0 + ai * HALF + m * 16) * D + col0;
#pragma unroll
                for (int bj = 0; bj < 2; ++bj)
#pragma unroll
                    for (int n = 0; n < 2; ++n) {
                        const f32x4 r = *(const f32x4*)(rb + ro + bj * HALF + n * 16);
                        *(f32x4*)(out + ro + bj * HALF + n * 16) = r + gv[bj][n] * acc[ai][bj][m][n];
                    }
            }
    }
};
struct EpiIn {
    bf16_t* PX; bf16_t* U; float* GK;
    __device__ __forceinline__ bool defer(const Unit&) const { return false; }
    __device__ __forceinline__ void fused(f32x4 (&)[2][2][4][2], const Unit&, int, int, int, int, LAS unsigned char*, int, int) const {}
    __device__ __forceinline__ void operator()(const f32x4 (&acc)[2][2][4][2], const Unit& u, int wr, int wc, int fr, int fq) const {
        const int row0 = u.pm * BM + wr * 64 + fr;
        if (u.pn < 12) {
            const int col0 = u.pn * BM + wc * 32 + 8 * fq;
#pragma unroll
            for (int ai = 0; ai < 2; ++ai)
#pragma unroll
                for (int m = 0; m < 4; ++m)
#pragma unroll
                    for (int bj = 0; bj < 2; ++bj) {
                        const f32x4 a = acc[ai][bj][m][0], b = acc[ai][bj][m][1];
                        u32x4 pk; pk[0] = cvt_pk_bf16(a[0], a[1]); pk[1] = cvt_pk_bf16(a[2], a[3]); pk[2] = cvt_pk_bf16(b[0], b[1]); pk[3] = cvt_pk_bf16(b[2], b[3]);
                        *(u32x4*)(PX + (size_t)(row0 + ai * HALF + m * 16) * PXW + col0 + bj * HALF) = pk;
                    }
        } else if (u.pn < 20) {
            const int col0 = (u.pn - 12) * 128 + wc * 32 + 8 * fq;
#pragma unroll
            for (int ai = 0; ai < 2; ++ai)
#pragma unroll
                for (int m = 0; m < 4; ++m) {
                    float o[8];
#pragma unroll
                    for (int n = 0; n < 2; ++n)
#pragma unroll
                        for (int i = 0; i < 4; ++i) o[n * 4 + i] = acc[ai][0][m][n][i] * sigmoid_f(acc[ai][1][m][n][i]);
                    u32x4 pk; pk[0] = cvt_pk_bf16(o[0], o[1]); pk[1] = cvt_pk_bf16(o[2], o[3]); pk[2] = cvt_pk_bf16(o[4], o[5]); pk[3] = cvt_pk_bf16(o[6], o[7]);
                    *(u32x4*)(U + (size_t)(row0 + ai * HALF + m * 16) * 1024 + col0) = pk;
                }
        } else {
            if (wc == 0) {
#pragma unroll
                for (int ai = 0; ai < 2; ++ai)
#pragma unroll
                    for (int m = 0; m < 4; ++m)
#pragma unroll
                        for (int n = 0; n < 2; ++n) *(f32x4*)(GK + (size_t)(row0 + ai * HALF + m * 16) * 32 + n * 16 + 4 * fq) = acc[ai][0][m][n];
            }
        }
    }
};

template <class Epi>
__device__ __forceinline__ void gemm_phase(LAS unsigned char* lds, const Gemm g, const Order& S, const Epi& E) {
    const int tid = otid(), wid = __builtin_amdgcn_readfirstlane(tid >> 6), lane = tid & 63, wr = wid >> 2, wc = wid & 3, fr = lane & 15, fq = lane >> 4;
    const int K = g.K;
    unsigned voffA[2];
#pragma unroll
    for (int i = 0; i < 2; ++i) { int R, C; stage_rc(tid * 16 + i * 8192, R, C); voffA[i] = (unsigned)(R * K + C) * 2u; }
    const size_t kstep = (size_t)(BK * 2);
    const size_t hstep = (size_t)HALF * K * 2;
    const size_t tstep = 2 * hstep;
    const unsigned ldsw = (unsigned)wid * 1024u;
    const int aoff = lds_byte(wr * 64 + fr, fq * 8), boff = lds_byte(wc * 32 + fr, fq * 8);
#define PG8_SA(b, h) (((b) * 2 + (h)) * HTB)
#define PG8_SB(b, h) ((4 + (b) * 2 + (h)) * HTB)
#define PG8_STAGE(bufoff, gbase) do { _Pragma("unroll") for (int _i = 0; _i < 2; ++_i) \
        __builtin_amdgcn_global_load_lds((const unsigned*)((const char*)(gbase) + voffA[_i]), (LAS unsigned*)(lds + (bufoff) + ldsw + _i * 8192), 16, 0, 0); } while (0)
#define PG8_LDA(dst, b, h) do { _Pragma("unroll") for (int m = 0; m < 4; ++m) _Pragma("unroll") for (int k = 0; k < 2; ++k) dst[m][k] = *(const LAS bf16x8*)(lds + PG8_SA(b, h) + aoff + m * 2048 + k * 1024); } while (0)
#define PG8_LDB(dst, b, h) do { _Pragma("unroll") for (int n = 0; n < 2; ++n) _Pragma("unroll") for (int k = 0; k < 2; ++k) dst[n][k] = *(const LAS bf16x8*)(lds + PG8_SB(b, h) + boff + n * 2048 + k * 1024); } while (0)
#define PG8_MMA(ai, bj, At, Bt) do { __builtin_amdgcn_s_setprio(1); _Pragma("unroll") for (int m = 0; m < 4; ++m) _Pragma("unroll") for (int n = 0; n < 2; ++n) _Pragma("unroll") for (int k = 0; k < 2; ++k) \
        acc[ai][bj][m][n] = __builtin_amdgcn_mfma_f32_16x16x32_bf16(Bt[n][k], At[m][k], acc[ai][bj][m][n], 0, 0, 0); __builtin_amdgcn_s_setprio(0); } while (0)
#define PG8_WAIT_V(n) asm volatile("s_waitcnt vmcnt(" #n ")" ::: "memory")
#define PG8_WAIT_L(n) asm volatile("s_waitcnt lgkmcnt(" #n ")" ::: "memory")
#define PG8_BAR __builtin_amdgcn_s_barrier()
#define PG8_SCHED __builtin_amdgcn_sched_barrier(0)
    Unit cur, nxt; int ui = 0;
    if (!S.next(0, cur)) return;
    f32x4 acc[2][2][4][2];
#pragma unroll
    for (int a = 0; a < 2; ++a)
#pragma unroll
        for (int b = 0; b < 2; ++b)
#pragma unroll
            for (int m = 0; m < 4; ++m)
#pragma unroll
                for (int n = 0; n < 2; ++n) acc[a][b][m][n] = (f32x4){0.f, 0.f, 0.f, 0.f};
    bf16x8 At[4][2], B0[2][2], B1[2][2];
    const char* cA = (const char*)g.A + (size_t)cur.pm * tstep + (size_t)cur.kt0 * kstep; const char* cB = (const char*)g.Bt + (size_t)cur.pn * tstep + (size_t)cur.kt0 * kstep;
    PG8_STAGE(PG8_SB(0, 0), cB); PG8_STAGE(PG8_SA(0, 0), cA); PG8_STAGE(PG8_SB(0, 1), cB + hstep); PG8_STAGE(PG8_SA(0, 1), cA + hstep);
    if (wr == 1) PG8_BAR;
    PG8_WAIT_V(4); PG8_BAR;
    PG8_STAGE(PG8_SB(1, 0), cB + kstep); PG8_STAGE(PG8_SA(1, 0), cA + kstep); PG8_STAGE(PG8_SB(1, 1), cB + hstep + kstep);
    PG8_WAIT_V(6); PG8_BAR;
    for (;;) {
        const bool has_next = S.next(ui + 1, nxt);
        const char* nA = has_next ? (const char*)g.A + (size_t)nxt.pm * tstep + (size_t)nxt.kt0 * kstep : cA; const char* nB = has_next ? (const char*)g.Bt + (size_t)nxt.pn * tstep + (size_t)nxt.kt0 * kstep : cB;
        const int nt = cur.nt;
        for (int t = 0; t < nt; t += 2) {
            const bool last = (t == nt - 2);
            const char* a1 = cA + (size_t)(t + 1) * kstep;
            const char* a2 = last ? nA : cA + (size_t)(t + 2) * kstep; const char* b2 = last ? nB : cB + (size_t)(t + 2) * kstep;
            const char* a3 = a2 + kstep; const char* b3 = b2 + kstep;
            PG8_LDB(B0, 0, 0); PG8_SCHED; PG8_LDA(At, 0, 0); PG8_STAGE(PG8_SA(1, 1), a1 + hstep);
            PG8_WAIT_L(8); PG8_BAR; PG8_WAIT_L(0); PG8_MMA(0, 0, At, B0); PG8_BAR; PG8_SCHED;
            PG8_LDB(B1, 0, 1); PG8_STAGE(PG8_SB(0, 0), b2);
            PG8_BAR; PG8_WAIT_L(0); PG8_MMA(0, 1, At, B1); PG8_BAR;
            PG8_LDA(At, 0, 1); PG8_STAGE(PG8_SA(0, 0), a2);
            PG8_BAR; PG8_WAIT_L(0); PG8_MMA(1, 0, At, B0); PG8_BAR; PG8_SCHED;
            PG8_STAGE(PG8_SB(0, 1), b2 + hstep);
            PG8_WAIT_V(6); PG8_BAR; PG8_MMA(1, 1, At, B1); PG8_BAR;
            PG8_LDB(B0, 1, 0); PG8_SCHED; PG8_LDA(At, 1, 0); PG8_STAGE(PG8_SA(0, 1), a2 + hstep);
            PG8_WAIT_L(8); PG8_BAR; PG8_WAIT_L(0); PG8_MMA(0, 0, At, B0); PG8_BAR; PG8_SCHED;
            PG8_LDB(B1, 1, 1); PG8_STAGE(PG8_SB(1, 0), b3);
            PG8_BAR; PG8_WAIT_L(0); PG8_MMA(0, 1, At, B1); PG8_BAR;
            PG8_LDA(At, 1, 1); PG8_STAGE(PG8_SA(1, 0), a3);
            PG8_BAR; PG8_WAIT_L(0); PG8_MMA(1, 0, At, B0); PG8_BAR; PG8_SCHED;
            PG8_STAGE(PG8_SB(1, 1), b3 + hstep);
            PG8_WAIT_V(6); PG8_BAR; PG8_MMA(1, 1, At, B1); PG8_BAR;
        }
        if (!E.defer(cur)) E(acc, cur, wr, wc, fr, fq);
        if (!has_next) break;
#pragma unroll
        for (int a = 0; a < 2; ++a)
#pragma unroll
            for (int b = 0; b < 2; ++b)
#pragma unroll
                for (int m = 0; m < 4; ++m)
#pragma unroll
                    for (int n = 0; n < 2; ++n) acc[a][b][m][n] = (f32x4){0.f, 0.f, 0.f, 0.f};
        cur = nxt; cA = nA; cB = nB; ++ui;
    }
    PG8_WAIT_V(0);
    if (wr == 0) PG8_BAR;
    PG8_BAR;
    if (E.defer(cur)) E.fused(acc, cur, wr, wc, fr, fq, lds, wid, lane);
#undef PG8_SA
#undef PG8_SB
#undef PG8_STAGE
#undef PG8_LDA
#undef PG8_LDB
#undef PG8_MMA
#undef PG8_WAIT_V
#undef PG8_WAIT_L
#undef PG8_BAR
#undef PG8_SCHED
}

__device__ __forceinline__ void gemv_item(const Params& p, LAS unsigned char* lds, int nt) {
    const int tid = otid();
    LAS float* sv = (LAS float*)lds;
    LAS float* red = sv + 3 * 2048;
    {
        float cvv[12];
#pragma unroll
        for (int q = 0; q < 12; ++q) { const int k = (tid + 512 * q) & 2047; cvv[q] = (q >> 2) < 2 ? p.c[(q >> 2) * 2048 + k] : p.c_ctx[k]; }
#pragma unroll
        for (int q = 0; q < 12; ++q) sv[tid + 512 * q] = cvv[q] / (1.f + __expf(-cvv[q]));
    }
    __syncthreads();
    const int cg4 = tid & 31, kl = tid >> 5;
    const float* wp = p.w_mod + (size_t)kl * NMOD + nt * 128 + cg4 * 4;
    f32x4 a0 = {0.f, 0.f, 0.f, 0.f}, a1 = a0, a2 = a0;
#pragma unroll 8
    for (int k = kl; k < 2048; k += 16) {
        const f32x4 w = __builtin_nontemporal_load((const f32x4*)wp); wp += (size_t)16 * NMOD;
        const float s0 = sv[k], s1 = sv[2048 + k], s2 = sv[4096 + k];
        a0 += w * s0; a1 += w * s1; a2 += w * s2;
    }
#pragma unroll
    for (int i = 0; i < 4; ++i) { red[(kl * 3 + 0) * 128 + cg4 * 4 + i] = a0[i]; red[(kl * 3 + 1) * 128 + cg4 * 4 + i] = a1[i]; red[(kl * 3 + 2) * 128 + cg4 * 4 + i] = a2[i]; }
    __syncthreads();
    if (tid < 384) {
        const int r = tid >> 7, col = tid & 127; float s = 0.f;
#pragma unroll
        for (int q = 0; q < 16; ++q) s += red[(q * 3 + r) * 128 + col];
        float* MOD = (float*)(p.ws + WS_MOD);
        MOD[r * NMOD + nt * 128 + col] = s + p.b_mod[nt * 128 + col];
    }
}

struct WcDesc { const float* src; bf16_t* dst; int K, Nsrc, perm, nvalid; };
__device__ __forceinline__ WcDesc wconv_decode(const Params& p, int it) {
    int w, loc;
    if (it < 1408) { w = 0; loc = it; } else if (it < 2112) { w = 1; loc = it - 1408; } else if (it < 2784) { w = 2; loc = it - 2112; }
    else if (it < 3040) { w = 3; loc = it - 2784; } else if (it < 4448) { w = 4; loc = it - 3040; } else { w = 5; loc = it - 4448; }
    const float* src; bf16_t* dst; int K, Nsrc, nR;
    switch (w) {
        case 0: src = p.w_ffn1_in; dst = (bf16_t*)(p.ws + WS_WT1); K = D; Nsrc = NFF; nR = 88; break;
        case 1: src = p.w_ffn1_out; dst = (bf16_t*)(p.ws + WS_WT2); K = DFF; Nsrc = D; nR = 16; break;
        case 2: src = p.w_in; dst = (bf16_t*)(p.ws + WS_WT3); K = D; Nsrc = NIN; nR = 42; break;
        case 3: src = p.w_out; dst = (bf16_t*)(p.ws + WS_WT4); K = D; Nsrc = D; nR = 16; break;
        case 4: src = p.w_ffn2_in; dst = (bf16_t*)(p.ws + WS_WT5); K = D; Nsrc = NFF; nR = 88; break;
        default: src = p.w_ffn2_out; dst = (bf16_t*)(p.ws + WS_WT6); K = DFF; Nsrc = D; nR = 16; break;
    }
    const int R = loc % nR, kt = loc / nR, k0 = kt * 128;
    int sbase, perm, nvalid = 128;
    if (w == 0 || w == 4) { sbase = (R & 1) * DFF + 128 * (R >> 1); perm = 1; }
    else if (w == 2) {
        if (R < 24) { sbase = 128 * R + (R >= 12 ? 32 : 0); perm = 1; }
        else if (R < 40) { const int q = R - 24; sbase = 3104 + (q & 1) * 1024 + 128 * (q >> 1); perm = 1; }
        else if (R == 40) { sbase = 1536; perm = 0; nvalid = 32; }
        else { sbase = 0; perm = 0; nvalid = 0; }
    } else { sbase = 128 * R; perm = 0; }
    WcDesc d; d.src = src + (size_t)k0 * Nsrc + sbase; d.dst = dst + (size_t)(128 * R) * K + k0; d.K = K; d.Nsrc = Nsrc; d.perm = perm; d.nvalid = nvalid;
    return d;
}
__device__ __forceinline__ void wconv_load(const WcDesc& d, int tid, f32x4 (&v)[2][4]) {
    const int cb = tid & 31;
#pragma unroll
    for (int iter = 0; iter < 2; ++iter) {
        const int kb = (tid >> 5) + 16 * iter;
#pragma unroll
        for (int kr = 0; kr < 4; ++kr) {
            if (4 * cb < d.nvalid) v[iter][kr] = __builtin_nontemporal_load((const f32x4*)(d.src + (size_t)(4 * kb + kr) * d.Nsrc + 4 * cb));
            else v[iter][kr] = (f32x4){0.f, 0.f, 0.f, 0.f};
        }
    }
}
__device__ __forceinline__ void wconv_lds(LAS unsigned char* lds, int tid, const f32x4 (&v)[2][4]) {
    const int cb = tid & 31;
#pragma unroll
    for (int iter = 0; iter < 2; ++iter) {
        const int kb = (tid >> 5) + 16 * iter;
#pragma unroll
        for (int ci = 0; ci < 4; ++ci) {
            u32x2 pk; pk[0] = cvt_pk_bf16(v[iter][0][ci], v[iter][1][ci]); pk[1] = cvt_pk_bf16(v[iter][2][ci], v[iter][3][ci]);
            *(LAS u32x2*)(lds + (4 * cb + ci) * 264 + 8 * kb) = pk;
        }
    }
}
__device__ __forceinline__ void wconv_out(const WcDesc& d, LAS unsigned char* lds, int tid) {
#pragma unroll
    for (int iter = 0; iter < 4; ++iter) {
        const int rr = (tid >> 4) + 32 * iter, kg = tid & 15;
        const int cc = d.perm ? ((rr & ~31) + perm32(rr & 31)) : rr;
        const u32x2 lo = *(const LAS u32x2*)(lds + cc * 264 + 16 * kg), hi = *(const LAS u32x2*)(lds + cc * 264 + 16 * kg + 8);
        u32x4 o; o[0] = lo[0]; o[1] = lo[1]; o[2] = hi[0]; o[3] = hi[1];
        __builtin_nontemporal_store(o, (u32x4*)(d.dst + (size_t)rr * d.K + 8 * kg));
    }
}
template <class MAP>
__device__ __forceinline__ void wconv_run(const Params& p, LAS unsigned char* lds, int first, int stride, int nloc, MAP map) {
    const int tid = otid();
    int it = first; if (it >= nloc) return;
    f32x4 v[2][4];
    WcDesc cur = wconv_decode(p, map(it));
    wconv_load(cur, tid, v);
    for (;;) {
        wconv_lds(lds, tid, v);
        __syncthreads();
        const int nx = it + stride; const bool has = nx < nloc;
        WcDesc nd = cur;
        if (has) { nd = wconv_decode(p, map(nx)); wconv_load(nd, tid, v); }
        wconv_out(cur, lds, tid);
        __syncthreads();
        if (!has) break;
        cur = nd; it = nx;
    }
}

__device__ __forceinline__ void phase_prep_weights(const Params& p, LAS unsigned char* lds) {
    for (int it = blockIdx.x; it < 144; it += gridDim.x) { gemv_item(p, lds, it); __syncthreads(); }
    const int G = gridDim.x; const int c = (int)((blockIdx.x + G - (144 % G)) % G);
    wconv_run(p, lds, c, G, 1408 + 672, [](int i) { return i < 1408 ? i : i - 1408 + 2112; });
}
__device__ __forceinline__ void wconv_tail(const Params& p, LAS unsigned char* lds, int nunits, int it0, int it1) {
    const int G = gridDim.x, first_idle = nunits % G, nidle = G - first_idle, c = blockIdx.x;
    if (c >= first_idle) wconv_run(p, lds, c - first_idle, nidle, it1 - it0, [it0](int i) { return i + it0; });
}

template <int MODE>
__device__ __forceinline__ void phase_modnorm(const Params& p, int row_begin, int nrows, const float* gain, int shift_idx, int scale_idx) {
    const int tid_ = otid(); const int wave = tid_ >> 6, lane = tid_ & 63;
    const float* MOD = (const float*)(p.ws + WS_MOD);
    const float* H1 = (const float*)(p.ws + WS_H1);
    bf16_t* ACT = (bf16_t*)(p.ws + WS_ACT);
    for (int row = row_begin + blockIdx.x * 8 + wave; row < nrows; row += gridDim.x * 8) {
        const float* src = MODE == 0 ? (row < TL ? p.x + (size_t)row * D : p.ctx + (size_t)(row - TL) * D) : (row < TL ? H1 + (size_t)row * D : p.ctx + (size_t)(row - TL) * D);
        const int set = row < 4096 ? 0 : (row < 8192 ? 1 : 2);
        const float* md = MOD + (size_t)set * NMOD;
        f32x4 v[8]; float ss = 0.f;
#pragma unroll
        for (int i = 0; i < 8; ++i) {
            v[i] = *(const f32x4*)(src + (i * 64 + lane) * 4);
            if (MODE == 1 && row >= TL) {
                const float* pp = (const float*)(p.ws + WS_PART) + (size_t)(row - TL) * D + (i * 64 + lane) * 4;
                f32x4 a = *(const f32x4*)pp;
#pragma unroll
                for (int ks = 1; ks < 11; ++ks) a += *(const f32x4*)(pp + (size_t)ks * TCX * D);
                v[i] += a * (*(const f32x4*)(md + 2 * D + (i * 64 + lane) * 4)) * 0.5f;
            }
            ss += v[i][0] * v[i][0] + v[i][1] * v[i][1] + v[i][2] * v[i][2] + v[i][3] * v[i][3]; }
        f32x4 gq[8], scq[8], shq[8];
#pragma unroll
        for (int i = 0; i < 8; ++i) {
            const int col = (i * 64 + lane) * 4;
            gq[i] = *(const f32x4*)(gain + col); scq[i] = *(const f32x4*)(md + scale_idx * D + col); shq[i] = *(const f32x4*)(md + shift_idx * D + col);
        }
        ss = wave_sum(ss);
        const float rs = rsqrtf(ss * (1.f / 2048.f) + 1e-6f);
#pragma unroll
        for (int i = 0; i < 8; ++i) {
            const int col = (i * 64 + lane) * 4;
            const f32x4 o = v[i] * rs * gq[i] * (scq[i] + 1.f) + shq[i];
            u32x2 pk; pk[0] = cvt_pk_bf16(o[0], o[1]); pk[1] = cvt_pk_bf16(o[2], o[3]);
            *(u32x2*)(ACT + (size_t)row * D + col) = pk;
        }
    }
}
__device__ __forceinline__ void phase_ctxnorm(const Params& p, LAS unsigned char* lds) {
    const int tid_ = otid(); const int wave = tid_ >> 6, lane = tid_ & 63, r = wave >> 2, qtr = wave & 3;
    const float* md = (const float*)(p.ws + WS_MOD) + (size_t)2 * NMOD;
    const float* PART = (const float*)(p.ws + WS_PART);
    bf16_t* ACT = (bf16_t*)(p.ws + WS_ACT);
    LAS float* red = (LAS float*)lds;
    for (int rp = blockIdx.x; rp < TCX / 2; rp += gridDim.x) {
        const int rc = rp * 2 + r;
        f32x4 v[2], a[2], m2[2]; f32x4 pr[2][11];
#pragma unroll
        for (int i = 0; i < 2; ++i) {
            const int col = qtr * 512 + (i * 64 + lane) * 4;
            v[i] = *(const f32x4*)(p.ctx + (size_t)rc * D + col);
            m2[i] = *(const f32x4*)(md + 2 * D + col);
#pragma unroll
            for (int ks = 0; ks < 11; ++ks) pr[i][ks] = *(const f32x4*)(PART + ((size_t)ks * TCX + rc) * D + col);
        }
        float ss = 0.f;
#pragma unroll
        for (int i = 0; i < 2; ++i) {
            a[i] = pr[i][0];
#pragma unroll
            for (int ks = 1; ks < 11; ++ks) a[i] += pr[i][ks];
            v[i] += a[i] * m2[i] * 0.5f;
            ss += v[i][0] * v[i][0] + v[i][1] * v[i][1] + v[i][2] * v[i][2] + v[i][3] * v[i][3];
        }
        ss = wave_sum(ss);
        if (lane == 0) red[wave] = ss;
        __syncthreads();
        const float tot = (red[r * 4] + red[r * 4 + 1]) + (red[r * 4 + 2] + red[r * 4 + 3]);
        const float rs = rsqrtf(tot * (1.f / 2048.f) + 1e-6f);
#pragma unroll
        for (int i = 0; i < 2; ++i) {
            const int col = qtr * 512 + (i * 64 + lane) * 4;
            const f32x4 g = *(const f32x4*)(p.norm_mix + col), sc = *(const f32x4*)(md + 4 * D + col), sh = *(const f32x4*)(md + 3 * D + col);
            const f32x4 o = v[i] * rs * g * (sc + 1.f) + sh;
            u32x2 pk; pk[0] = cvt_pk_bf16(o[0], o[1]); pk[1] = cvt_pk_bf16(o[2], o[3]);
            *(u32x2*)(ACT + (size_t)(TL + rc) * D + col) = pk;
        }
        __syncthreads();
    }
}
__device__ __forceinline__ void phase_final(const Params& p) {
    const int tid_ = otid(); const int wave = tid_ >> 6, lane = tid_ & 63;
    const float* H1 = (const float*)(p.ws + WS_H1);
    for (int row = blockIdx.x * 8 + wave; row < TL; row += gridDim.x * 8) {
        const float* src = H1 + (size_t)row * D;
        f32x4 v[8]; float ss = 0.f;
#pragma unroll
        for (int i = 0; i < 8; ++i) { v[i] = *(const f32x4*)(src + (i * 64 + lane) * 4); ss += v[i][0] * v[i][0] + v[i][1] * v[i][1] + v[i][2] * v[i][2] + v[i][3] * v[i][3]; }
        ss = wave_sum(ss);
        const float rs = rsqrtf(ss * (1.f / 2048.f) + 1e-6f);
#pragma unroll
        for (int i = 0; i < 8; ++i) {
            const int col = (i * 64 + lane) * 4;
            const f32x4 g = *(const f32x4*)(p.norm_final + col);
            *(f32x4*)(p.out + (size_t)row * D + col) = v[i] * rs * g;
        }
    }
}

constexpr int L_GKS = 0;
constexpr int L_BC = 8192;
constexpr int L_VT = L_BC + 33024;
constexpr int L_T0 = L_VT + 36864;
constexpr int L_QS = L_T0, L_KS = L_T0 + 17408, L_QE = L_T0 + 2 * 17408, L_ATT = L_T0 + 3 * 17408, L_RED = L_ATT + 9216;
constexpr int L_TOT = L_RED + 2048;
static_assert(L_TOT + 4096 <= LDS_BYTES - 16, "LDS");

__device__ __forceinline__ void gla_stage_common(const Params& p, LAS unsigned char* lds, int row0, int h) {
    const int tid = otid();
    const float* GK = (const float*)(p.ws + WS_GK);
    const bf16_t* PX = (const bf16_t*)(p.ws + WS_PX);
    const int t4 = tid & 15, eg = tid >> 4;
    const f32x4 gkv = *(const f32x4*)(GK + (size_t)(row0 + (tid >> 3)) * 32 + (tid & 7) * 4);
    u32x4 vv[4];
#pragma unroll
    for (int i = 0; i < 4; ++i) vv[i] = *(const u32x4*)(PX + (size_t)(row0 + 4 * t4 + i) * PXW + 512 + h * 256 + eg * 8);
    asm volatile("" :: "v"(gkv), "v"(vv[0]), "v"(vv[1]), "v"(vv[2]), "v"(vv[3]));
    *(LAS f32x4*)(lds + L_GKS + ((tid >> 3) * 32 + (tid & 7) * 4) * 4) = gkv;
#pragma unroll
    for (int k = 0; k < 4; ++k) {
        u32x2 lo, hi;
        lo[0] = (vv[0][k] & 0xffffu) | (vv[1][k] << 16); lo[1] = (vv[2][k] & 0xffffu) | (vv[3][k] << 16);
        hi[0] = (vv[0][k] >> 16) | (vv[1][k] & 0xffff0000u); hi[1] = (vv[2][k] >> 16) | (vv[3][k] & 0xffff0000u);
        *(LAS u32x2*)(lds + L_VT + ((eg * 8 + 2 * k) * 72 + 4 * t4) * 2) = lo;
        *(LAS u32x2*)(lds + L_VT + ((eg * 8 + 2 * k + 1) * 72 + 4 * t4) * 2) = hi;
    }
}
__device__ __forceinline__ void gla_load_w2(const Params& p, int h, int d, int tid, float (&w2r)[16], float& b2) {
    const int j = tid & 127;
#pragma unroll
    for (int r = 0; r < 16; ++r) w2r[r] = p.w_gk2[(size_t)(d * 16 + r) * 512 + h * 128 + j];
    b2 = p.b_gk2[d * 512 + h * 128 + j];
}
__device__ __forceinline__ void gla_logdecay16w(LAS unsigned char* lds, int d, int tid, const float (&w2r)[16], float b2, float (&ld)[16]) {
    const int seg = tid >> 7;
    LAS float* gks = (LAS float*)(lds + L_GKS);
#pragma unroll
    for (int tt = 0; tt < 16; ++tt) {
        const int t = 16 * seg + tt;
        float z = b2;
#pragma unroll
        for (int r4 = 0; r4 < 4; ++r4) {
            const f32x4 gv = *(const LAS f32x4*)(gks + t * 32 + d * 16 + r4 * 4);
            z += gv[0] * w2r[r4 * 4] + gv[1] * w2r[r4 * 4 + 1] + gv[2] * w2r[r4 * 4 + 2] + gv[3] * w2r[r4 * 4 + 3];
        }
        const float e2 = __builtin_amdgcn_exp2f(fabsf(z) * -1.4426950408889634f);
        ld[tt] = fminf(z, 0.f) * (1.f / 16.f) - 0.04332169878499658f * __builtin_amdgcn_logf(1.f + e2);
    }
}
__device__ __forceinline__ void gla_logdecay16(const Params& p, LAS unsigned char* lds, int h, int d, int tid, float (&ld)[16]) {
    float w2r[16], b2; gla_load_w2(p, h, d, tid, w2r, b2); gla_logdecay16w(lds, d, tid, w2r, b2, ld);
}
__device__ __forceinline__ void gla_cumdecay(const Params& p, LAS unsigned char* lds, int h, int d) {
    const int tid = otid(), j = tid & 127, seg = tid >> 7;
    LAS float* bc = (LAS float*)(lds + L_BC);
    LAS float* tot = (LAS float*)(lds + L_TOT);
    float ld[16];
    gla_logdecay16(p, lds, h, d, tid, ld);
    float run = 0.f;
    if (d == 0) {
#pragma unroll
        for (int tt = 0; tt < 16; ++tt) { run += ld[tt]; ld[tt] = run; }
    } else {
#pragma unroll
        for (int tt = 15; tt >= 0; --tt) { run += ld[tt]; ld[tt] = run; }
    }
    tot[seg * 128 + j] = run;
    __syncthreads();
    float off = 0.f;
#pragma unroll
    for (int sg = 0; sg < 4; ++sg) { const float tv = tot[sg * 128 + j]; const bool use = d == 0 ? (sg < seg) : (sg > seg); off += use ? tv : 0.f; }
#pragma unroll
    for (int tt = 0; tt < 16; ++tt) bc[(16 * seg + tt) * 129 + j] = ld[tt] + off;
    __syncthreads();
}

__device__ __forceinline__ void gla_a_item(const Params& p, LAS unsigned char* lds, int item, int dsel) {
    const int tid = otid(), wid = tid >> 6, lane = tid & 63, fr = lane & 15, fq = lane >> 4;
    const int bh = item / NSLOT, slot = item % NSLOT, b = bh >> 2, h = bh & 3;
    const int row0 = slot < 4 ? TL + b * 256 + slot * 64 : b * 4096 + (slot - 4) * 64;
    const bf16_t* PX = (const bf16_t*)(p.ws + WS_PX);
    bf16_t* KVT = (bf16_t*)(p.ws + WS_HID);
    float* DEC = (float*)(p.ws + WS_DEC);
    LAS float* tot = (LAS float*)(lds + L_TOT);
    const int j = tid & 127, seg = tid >> 7;
    gla_stage_common(p, lds, row0, h);
    float kf[16];
#pragma unroll
    for (int tt = 0; tt < 16; ++tt) kf[tt] = bf_lo((unsigned)PX[(size_t)(row0 + 16 * seg + tt) * PXW + h * 128 + j]);
    float w2f[16], w2b[16], b2f, b2b;
    gla_load_w2(p, h, 0, tid, w2f, b2f); gla_load_w2(p, h, 1, tid, w2b, b2b);
    __syncthreads();
    const bool do_f = dsel != 2, do_b = dsel != 1;
    float lf[16], lb[16];
    if (do_f) gla_logdecay16w(lds, 0, tid, w2f, b2f, lf); else {
#pragma unroll
        for (int q = 0; q < 16; ++q) lf[q] = 0.f; }
    if (do_b) gla_logdecay16w(lds, 1, tid, w2b, b2b, lb); else {
#pragma unroll
        for (int q = 0; q < 16; ++q) lb[q] = 0.f; }
    float tf = 0.f, tb = 0.f;
#pragma unroll
    for (int tt = 15; tt >= 0; --tt) { const float v = lf[tt]; lf[tt] = tf; tf += v; }
#pragma unroll
    for (int tt = 0; tt < 16; ++tt) { const float v = lb[tt]; lb[tt] = tb; tb += v; }
    tot[seg * 128 + j] = tf; tot[512 + seg * 128 + j] = tb;
    __syncthreads();
    float of = 0.f, ob = 0.f, sf = 0.f, sb = 0.f;
#pragma unroll
    for (int sg = 0; sg < 4; ++sg) { const float a = tot[sg * 128 + j], c = tot[512 + sg * 128 + j]; sf += a; sb += c; of += sg > seg ? a : 0.f; ob += sg < seg ? c : 0.f; }
    if (do_f) {
        u32x4 w0, w1;
#pragma unroll
        for (int q = 0; q < 4; ++q) {
            w0[q] = cvt_pk_bf16(kf[2 * q] * __expf(lf[2 * q] + of), kf[2 * q + 1] * __expf(lf[2 * q + 1] + of));
            w1[q] = cvt_pk_bf16(kf[8 + 2 * q] * __expf(lf[8 + 2 * q] + of), kf[8 + 2 * q + 1] * __expf(lf[8 + 2 * q + 1] + of));
        }
        *(LAS u32x4*)(lds + L_T0 + (j * 72 + 16 * seg) * 2) = w0; *(LAS u32x4*)(lds + L_T0 + (j * 72 + 16 * seg + 8) * 2) = w1;
    }
    if (do_b) {
        u32x4 w2, w3;
#pragma unroll
        for (int q = 0; q < 4; ++q) {
            w2[q] = cvt_pk_bf16(kf[2 * q] * __expf(lb[2 * q] + ob), kf[2 * q + 1] * __expf(lb[2 * q + 1] + ob));
            w3[q] = cvt_pk_bf16(kf[8 + 2 * q] * __expf(lb[8 + 2 * q] + ob), kf[8 + 2 * q + 1] * __expf(lb[8 + 2 * q + 1] + ob));
        }
        *(LAS u32x4*)(lds + L_T0 + 18432 + (j * 72 + 16 * seg) * 2) = w2; *(LAS u32x4*)(lds + L_T0 + 18432 + (j * 72 + 16 * seg + 8) * 2) = w3;
    }
    if (slot >= 4) {
        float bef = 0.f, aft = 0.f;
#pragma unroll
        for (int sg = 0; sg < 4; ++sg) { bef += sg < seg ? tot[sg * 128 + j] : 0.f; aft += sg > seg ? tot[512 + sg * 128 + j] : 0.f; }
        float* bcf = (float*)(p.ws + WS_BC) + (((size_t)(0 * 8 + bh) * 64 + (slot - 4)) * 64 + 16 * seg) * 128 + j;
        float* bcb = (float*)(p.ws + WS_BC) + (((size_t)(1 * 8 + bh) * 64 + (slot - 4)) * 64 + 16 * seg) * 128 + j;
#pragma unroll
        for (int tt = 0; tt < 16; ++tt) { if (do_f) bcf[tt * 128] = (tf - lf[tt]) + bef; if (do_b) bcb[tt * 128] = (tb - lb[tt]) + aft; }
        bf16_t* vtg = (bf16_t*)(p.ws + WS_VT) + ((size_t)bh * 64 + (slot - 4)) * 256 * 64;
        if (do_f)
#pragma unroll
        for (int it = 0; it < 4; ++it) {
            const int id = tid + 512 * it, e = id >> 3, cq = id & 7;
            *(u32x4*)(vtg + e * 64 + cq * 8) = *(const LAS u32x4*)(lds + L_VT + e * 144 + cq * 16);
        }
    }
    if (seg == 0 && do_f) DEC[((size_t)(0 * 8 + bh) * NSLOT + slot) * 128 + j] = __expf(sf);
    if (seg == 1 && do_b) DEC[((size_t)(1 * 8 + bh) * NSLOT + slot) * 128 + j] = __expf(sb);
    __syncthreads();
    for (int d = 0; d < 2; ++d) {
        if (d == 0 ? !do_f : !do_b) continue;
        f32x4 acc[2][8];
#pragma unroll
        for (int et = 0; et < 2; ++et)
#pragma unroll
            for (int jt = 0; jt < 8; ++jt) acc[et][jt] = (f32x4){0.f, 0.f, 0.f, 0.f};
#pragma unroll
        for (int ks = 0; ks < 2; ++ks) {
            bf16x8 bv[2];
#pragma unroll
            for (int et = 0; et < 2; ++et) bv[et] = *(const LAS bf16x8*)(lds + L_VT + (32 * wid + 16 * et + fr) * 144 + (ks * 32 + fq * 8) * 2);
#pragma unroll
            for (int jt = 0; jt < 8; ++jt) {
                const bf16x8 av = *(const LAS bf16x8*)(lds + L_T0 + d * 18432 + (16 * jt + fr) * 144 + (ks * 32 + fq * 8) * 2);
#pragma unroll
                for (int et = 0; et < 2; ++et) acc[et][jt] = __builtin_amdgcn_mfma_f32_16x16x32_bf16(av, bv[et], acc[et][jt], 0, 0, 0);
            }
        }
        bf16_t* kvb = KVT + ((size_t)(d * 8 + bh) * NSLOT + slot) * 32768;
#pragma unroll
        for (int et = 0; et < 2; ++et)
#pragma unroll
            for (int jt = 0; jt < 8; ++jt) {
                u32x2 pk; pk[0] = cvt_pk_bf16(acc[et][jt][0], acc[et][jt][1]); pk[1] = cvt_pk_bf16(acc[et][jt][2], acc[et][jt][3]);
                *(u32x2*)(kvb + (32 * wid + 16 * et + fr) * 128 + 16 * jt + 4 * fq) = pk;
            }
    }
}

template <int NT>
__device__ __forceinline__ void conv_window(const bf16_t* ubase, size_t stride_el, int p0, const LAS float* cwl, float (*y)[8]) {
    constexpr int PFD = 8;
    float wv[NT][8]; u32x4 pf[PFD];
    const bf16_t* ptr = ubase + (ptrdiff_t)p0 * (ptrdiff_t)stride_el;
#pragma unroll
    for (int q = 0; q < NT; ++q) {
        u32x4 v = *(const u32x4*)ptr; ptr += stride_el;
        const int pos = p0 + q; if (pos < 0 || pos > 63) v = (u32x4){0u, 0u, 0u, 0u};
#pragma unroll
        for (int i = 0; i < 4; ++i) { wv[q][2 * i] = bf_lo(v[i]); wv[q][2 * i + 1] = bf_hi(v[i]); }
    }
#pragma unroll
    for (int q = 0; q < PFD; ++q) { pf[q] = *(const u32x4*)ptr; ptr += stride_el; }
#pragma unroll 1
    for (int j0 = 0; j0 < 32; j0 += 8) {
#pragma unroll
        for (int jj = 0; jj < 8; ++jj) {
            const int j = j0 + jj;
            const f32x4 c0 = *(const LAS f32x4*)(cwl + j * 1024), c1 = *(const LAS f32x4*)(cwl + j * 1024 + 4);
#pragma unroll
            for (int tk = 0; tk < NT; ++tk) {
                const float (&w)[8] = wv[(tk + jj) % NT];
                y[tk][0] += w[0] * c0[0]; y[tk][1] += w[1] * c0[1]; y[tk][2] += w[2] * c0[2]; y[tk][3] += w[3] * c0[3];
                y[tk][4] += w[4] * c1[0]; y[tk][5] += w[5] * c1[1]; y[tk][6] += w[6] * c1[2]; y[tk][7] += w[7] * c1[3];
            }
            {
                u32x4 v = pf[jj];
                const int pos = p0 + NT + j; if (pos < 0 || pos > 63) v = (u32x4){0u, 0u, 0u, 0u};
                float (&w)[8] = wv[jj % NT];
#pragma unroll
                for (int i = 0; i < 4; ++i) { w[2 * i] = bf_lo(v[i]); w[2 * i + 1] = bf_hi(v[i]); }
            }
            pf[jj] = *(const u32x4*)ptr; ptr += stride_el;
        }
    }
}
__device__ __forceinline__ void conv_item(const Params& p, LAS unsigned char* lds, int item) {
    const int tid = otid(), wid = tid >> 6;
    const int b = item >> 7, r0 = ((item >> 3) & 15) * 4, w0 = (item & 7) * 8;
    const bf16_t* U = (const bf16_t*)(p.ws + WS_U);
    bf16_t* OCAT = (bf16_t*)(p.ws + WS_ACT);
    LAS float* red = (LAS float*)lds;
    const int cg = tid & 127, ch = cg * 8, tg = tid >> 7;
    const bool rowconv = cg < 64;
    float bias[8], lg[8], lb[8];
    { const f32x4 b0 = *(const f32x4*)(p.conv_b + ch), b1 = *(const f32x4*)(p.conv_b + ch + 4);
      const f32x4 g0 = *(const f32x4*)(p.conv_ln_g + ch), g1 = *(const f32x4*)(p.conv_ln_g + ch + 4);
      const f32x4 l0 = *(const f32x4*)(p.conv_ln_b + ch), l1 = *(const f32x4*)(p.conv_ln_b + ch + 4);
#pragma unroll
      for (int i = 0; i < 4; ++i) { bias[i] = b0[i]; bias[4 + i] = b1[i]; lg[i] = g0[i]; lg[4 + i] = g1[i]; lb[i] = l0[i]; lb[4 + i] = l1[i]; } }
    LAS float* cwl = (LAS float*)(lds + 512);
    {
        f32x4 cwv[16];
#pragma unroll
        for (int q = 0; q < 16; ++q) { const int i = tid + 512 * q; const int ic = i < 31 * 256 ? i : 0; cwv[q] = *(const f32x4*)(p.conv_w + ic * 4); if (i >= 31 * 256) cwv[q] = (f32x4){0.f, 0.f, 0.f, 0.f}; }
#pragma unroll
        for (int q = 0; q < 16; ++q) *(LAS f32x4*)(cwl + (tid + 512 * q) * 4) = cwv[q];
    }
    __syncthreads();
    float y[8][8];
#pragma unroll
    for (int tk = 0; tk < 8; ++tk)
#pragma unroll
        for (int i = 0; i < 8; ++i) y[tk][i] = bias[i];
    int ltok[8];
    if (rowconv) {
        conv_window<8>(U + (size_t)(b * 4096 + (r0 + tg) * 64) * 1024 + ch, 1024, w0 - 15, cwl + ch, &y[0]);
#pragma unroll
        for (int tk = 0; tk < 8; ++tk) ltok[tk] = tg * 8 + tk;
    } else {
        conv_window<4>(U + (size_t)(b * 4096 + w0 + 2 * tg) * 1024 + ch, 64 * 1024, r0 - 15, cwl + ch, &y[0]);
        conv_window<4>(U + (size_t)(b * 4096 + w0 + 2 * tg + 1) * 1024 + ch, 64 * 1024, r0 - 15, cwl + ch, &y[4]);
#pragma unroll
        for (int tk = 0; tk < 8; ++tk) ltok[tk] = (tk & 3) * 8 + 2 * tg + (tk >> 2);
    }
    const int half = rowconv ? 0 : 1;
#pragma unroll
    for (int tk = 0; tk < 8; ++tk) {
        float s1 = 0.f, s2 = 0.f;
#pragma unroll
        for (int i = 0; i < 8; ++i) { s1 += y[tk][i]; s2 += y[tk][i] * y[tk][i]; }
        s1 = wave_sum(s1); s2 = wave_sum(s2);
        if ((tid & 63) == 0) { red[(ltok[tk] * 2 + half) * 2] = s1; red[(ltok[tk] * 2 + half) * 2 + 1] = s2; }
    }
    __syncthreads();
#pragma unroll
    for (int tk = 0; tk < 8; ++tk) {
        const int lt = ltok[tk];
        const float mean = (red[lt * 4] + red[lt * 4 + 2]) * (1.f / 1024.f);
        const float var = (red[lt * 4 + 1] + red[lt * 4 + 3]) * (1.f / 1024.f) - mean * mean;
        const float rstd = rsqrtf(fmaxf(var, 0.f) + 1e-5f);
        float o[8];
#pragma unroll
        for (int i = 0; i < 8; ++i) { const float yn = (y[tk][i] - mean) * rstd * lg[i] + lb[i]; o[i] = silu_f(yn); }
        u32x4 pk; pk[0] = cvt_pk_bf16(o[0], o[1]); pk[1] = cvt_pk_bf16(o[2], o[3]); pk[2] = cvt_pk_bf16(o[4], o[5]); pk[3] = cvt_pk_bf16(o[6], o[7]);
        const int tok = b * 4096 + (r0 + (lt >> 3)) * 64 + w0 + (lt & 7);
        if (DBG_ZERO_CONV) { pk[0] = 0; pk[1] = 0; pk[2] = 0; pk[3] = 0; }
        *(u32x4*)(OCAT + (size_t)tok * D + 1024 + ch) = pk;
    }
    (void)wid;
}

__device__ __forceinline__ void phase_gla_a_conv(const Params& p, LAS unsigned char* lds) {
    const int nItems = 256 + 512 + 64;
    for (int it = blockIdx.x; it < nItems; it += gridDim.x) {
        if (it < 256) conv_item(p, lds, it);
        else if (it < 768) gla_a_item(p, lds, it - 256, 0);
        else { const int hh = it - 768; gla_a_item(p, lds, 512 + (hh >> 1), 1 + (hh & 1)); }
        __syncthreads();
    }
}

template <int DIR>
__device__ __forceinline__ void scan_one(bf16_t* base, const float* db) {
    f32x4 S = {0.f, 0.f, 0.f, 0.f};
    {
        u32x2 kv[4]; f32x4 dc[4];
#pragma unroll
        for (int q = 0; q < 4; ++q) { const int slot = DIR == 0 ? q : 3 - q; kv[q] = *(const u32x2*)(base + (size_t)slot * 32768); dc[q] = *(const f32x4*)(db + slot * 128); }
#pragma unroll
        for (int q = 0; q < 4; ++q) { S[0] = dc[q][0] * S[0] + bf_lo(kv[q][0]); S[1] = dc[q][1] * S[1] + bf_hi(kv[q][0]); S[2] = dc[q][2] * S[2] + bf_lo(kv[q][1]); S[3] = dc[q][3] * S[3] + bf_hi(kv[q][1]); }
    }
#pragma unroll 1
    for (int b0 = 0; b0 < 64; b0 += 16) {
        u32x2 kv[16]; f32x4 dc[16];
#pragma unroll
        for (int q = 0; q < 16; ++q) { const int slot = DIR == 0 ? 4 + b0 + q : 67 - b0 - q; kv[q] = *(const u32x2*)(base + (size_t)slot * 32768); dc[q] = *(const f32x4*)(db + slot * 128); }
#pragma unroll
        for (int q = 0; q < 16; ++q) {
            const int slot = DIR == 0 ? 4 + b0 + q : 67 - b0 - q;
            u32x2 pk; pk[0] = cvt_pk_bf16(S[0], S[1]); pk[1] = cvt_pk_bf16(S[2], S[3]);
            *(u32x2*)(base + (size_t)slot * 32768) = pk;
            S[0] = dc[q][0] * S[0] + bf_lo(kv[q][0]); S[1] = dc[q][1] * S[1] + bf_hi(kv[q][0]); S[2] = dc[q][2] * S[2] + bf_lo(kv[q][1]); S[3] = dc[q][3] * S[3] + bf_hi(kv[q][1]);
        }
    }
}
__device__ __forceinline__ void phase_scan(const Params& p) {
    bf16_t* KVT = (bf16_t*)(p.ws + WS_HID);
    const float* DEC = (const float*)(p.ws + WS_DEC);
    for (int gid = blockIdx.x * 512 + otid(); gid < 2 * 8 * 256 * 32; gid += gridDim.x * 512) {
        const int d = gid >> 16, bh = (gid >> 13) & 7, e = (gid >> 5) & 255, jg = gid & 31;
        bf16_t* base = KVT + (size_t)(d * 8 + bh) * NSLOT * 32768 + e * 128 + jg * 4;
        const float* db = DEC + (size_t)(d * 8 + bh) * NSLOT * 128 + jg * 4;
        if (d == 0) scan_one<0>(base, db); else scan_one<1>(base, db);
    }
}

__device__ __forceinline__ void gla_c_item(const Params& p, LAS unsigned char* lds, int item) {
    const int tid = otid(), wid = tid >> 6, lane = tid & 63, fr = lane & 15, fq = lane >> 4;
    const int bh = item >> 6, n = item & 63, b = bh >> 2, h = bh & 3, slot = 4 + n;
    const int row0 = b * 4096 + n * 64;
    const bf16_t* PX = (const bf16_t*)(p.ws + WS_PX);
    const bf16_t* KVT = (const bf16_t*)(p.ws + WS_HID);
    bf16_t* OCAT = (bf16_t*)(p.ws + WS_ACT);
    LAS float* bc = (LAS float*)(lds + L_BC);
    const float* bcg = (const float*)(p.ws + WS_BC) + ((size_t)bh * 64 + n) * 64 * 128;
    f32x4 bcv[2][4];
#pragma unroll
    for (int d = 0; d < 2; ++d)
#pragma unroll
        for (int it = 0; it < 4; ++it) bcv[d][it] = *(const f32x4*)(bcg + (size_t)d * 8 * 64 * 64 * 128 + (size_t)(tid + 512 * it) * 4);
    const bf16_t* vtg = (const bf16_t*)(p.ws + WS_VT) + ((size_t)bh * 64 + n) * 256 * 64;
    bf16x8 vfr[2][2];
#pragma unroll
    for (int ks = 0; ks < 2; ++ks)
#pragma unroll
        for (int et = 0; et < 2; ++et) vfr[ks][et] = *(const bf16x8*)(vtg + (32 * wid + 16 * et + fr) * 64 + ks * 32 + fq * 8);
    f32x4 o[2][4];
#pragma unroll
    for (int et = 0; et < 2; ++et)
#pragma unroll
        for (int tt = 0; tt < 4; ++tt) o[et][tt] = (f32x4){0.f, 0.f, 0.f, 0.f};
    for (int d = 0; d < 2; ++d) {
#pragma unroll
        for (int it = 0; it < 4; ++it) {
            const int id = tid + 512 * it, t = id >> 5, j4 = (id & 31) * 4;
            const f32x4 v = d == 0 ? bcv[0][it] : bcv[1][it];
            bc[t * 129 + j4] = v[0]; bc[t * 129 + j4 + 1] = v[1]; bc[t * 129 + j4 + 2] = v[2]; bc[t * 129 + j4 + 3] = v[3];
        }
        __syncthreads();
        const int tm = d == 0 ? 31 : 32;
        { const int t = tid & 63;
#pragma unroll
          for (int it = 0; it < 2; ++it) {
              const int jg = (tid >> 6) + 8 * it;
              const u32x4 qv = *(const u32x4*)(PX + (size_t)(row0 + t) * PXW + 1536 + h * 128 + jg * 8);
              const u32x4 kv = *(const u32x4*)(PX + (size_t)(row0 + t) * PXW + h * 128 + jg * 8);
              float qs[8], ks[8], qe[8];
#pragma unroll
              for (int i = 0; i < 8; ++i) {
                  const int j = jg * 8 + i;
                  const float qf = ((i & 1) ? bf_hi(qv[i >> 1]) : bf_lo(qv[i >> 1])) * 0.08838834764831845f;
                  const float kf = (i & 1) ? bf_hi(kv[i >> 1]) : bf_lo(kv[i >> 1]);
                  const float bb = bc[t * 129 + j], bm = bc[tm * 129 + j];
                  qs[i] = qf * __expf(bb - bm); ks[i] = kf * __expf(bm - bb); qe[i] = qf * __expf(bb);
              }
              u32x4 a, c, e;
#pragma unroll
              for (int i = 0; i < 4; ++i) { a[i] = cvt_pk_bf16(qs[2 * i], qs[2 * i + 1]); c[i] = cvt_pk_bf16(ks[2 * i], ks[2 * i + 1]); e[i] = cvt_pk_bf16(qe[2 * i], qe[2 * i + 1]); }
              *(LAS u32x4*)(lds + L_QS + t * 272 + jg * 16) = a;
              *(LAS u32x4*)(lds + L_KS + t * 272 + jg * 16) = c;
              *(LAS u32x4*)(lds + L_QE + t * 272 + jg * 16) = e;
          } }
        __syncthreads();
        { const int tt = wid & 3;
#pragma unroll
          for (int sh = 0; sh < 2; ++sh) {
              const int st = (wid >> 2) * 2 + sh;
              f32x4 a = {0.f, 0.f, 0.f, 0.f};
#pragma unroll
              for (int ks = 0; ks < 4; ++ks) {
                  const bf16x8 av = *(const LAS bf16x8*)(lds + L_KS + (16 * st + fr) * 272 + (ks * 32 + fq * 8) * 2);
                  const bf16x8 bv = *(const LAS bf16x8*)(lds + L_QS + (16 * tt + fr) * 272 + (ks * 32 + fq * 8) * 2);
                  a = __builtin_amdgcn_mfma_f32_16x16x32_bf16(av, bv, a, 0, 0, 0);
              }
              const int t = 16 * tt + fr, s0 = 16 * st + 4 * fq;
              float m[4];
#pragma unroll
              for (int i = 0; i < 4; ++i) { const int s = s0 + i; const bool keep = d == 0 ? (s <= t) : (s >= t); m[i] = keep ? a[i] : 0.f; }
              u32x2 pk; pk[0] = cvt_pk_bf16(m[0], m[1]); pk[1] = cvt_pk_bf16(m[2], m[3]);
              *(LAS u32x2*)(lds + L_ATT + t * 144 + s0 * 2) = pk;
          } }
        __syncthreads();
#pragma unroll
        for (int ks = 0; ks < 2; ++ks) {
#pragma unroll
            for (int tt = 0; tt < 4; ++tt) {
                const bf16x8 bv = *(const LAS bf16x8*)(lds + L_ATT + (16 * tt + fr) * 144 + (ks * 32 + fq * 8) * 2);
#pragma unroll
                for (int et = 0; et < 2; ++et) o[et][tt] = __builtin_amdgcn_mfma_f32_16x16x32_bf16(vfr[ks][et], bv, o[et][tt], 0, 0, 0);
            }
        }
        const bf16_t* sb = KVT + ((size_t)(d * 8 + bh) * NSLOT + slot) * 32768;
#pragma unroll
        for (int ks = 0; ks < 4; ++ks) {
            bf16x8 av[2];
#pragma unroll
            for (int et = 0; et < 2; ++et) av[et] = *(const bf16x8*)(sb + (32 * wid + 16 * et + fr) * 128 + ks * 32 + fq * 8);
#pragma unroll
            for (int tt = 0; tt < 4; ++tt) {
                const bf16x8 bv = *(const LAS bf16x8*)(lds + L_QE + (16 * tt + fr) * 272 + (ks * 32 + fq * 8) * 2);
#pragma unroll
                for (int et = 0; et < 2; ++et) o[et][tt] = __builtin_amdgcn_mfma_f32_16x16x32_bf16(av[et], bv, o[et][tt], 0, 0, 0);
            }
        }
        __syncthreads();
    }
    LAS float* red = (LAS float*)(lds + L_RED);
#pragma unroll
    for (int tt = 0; tt < 4; ++tt) {
        float s = 0.f;
#pragma unroll
        for (int et = 0; et < 2; ++et)
#pragma unroll
            for (int i = 0; i < 4; ++i) s += o[et][tt][i] * o[et][tt][i];
        s += __shfl_xor(s, 16, 64); s += __shfl_xor(s, 32, 64);
        if (fq == 0) red[wid * 64 + 16 * tt + fr] = s;
    }
    __syncthreads();
#pragma unroll
    for (int tt = 0; tt < 4; ++tt) {
        const int t = 16 * tt + fr;
        float tot = 0.f;
#pragma unroll
        for (int w = 0; w < 8; ++w) tot += red[w * 64 + t];
        const float rs = rsqrtf(tot * (1.f / 256.f) + 1e-5f);
#pragma unroll
        for (int et = 0; et < 2; ++et) {
            const int e = 32 * wid + 16 * et + 4 * fq;
            const f32x4 gn = *(const f32x4*)(p.gla_norm + e);
            const u32x2 gv = *(const u32x2*)(PX + (size_t)(row0 + t) * PXW + 2048 + h * 256 + e);
            const float g0 = bf_lo(gv[0]), g1 = bf_hi(gv[0]), g2 = bf_lo(gv[1]), g3 = bf_hi(gv[1]);
            const float v0 = o[et][tt][0] * rs * gn[0] * silu_f(g0), v1 = o[et][tt][1] * rs * gn[1] * silu_f(g1);
            const float v2 = o[et][tt][2] * rs * gn[2] * silu_f(g2), v3 = o[et][tt][3] * rs * gn[3] * silu_f(g3);
            u32x2 pk; pk[0] = cvt_pk_bf16(v0, v1); pk[1] = cvt_pk_bf16(v2, v3);
            if (DBG_ZERO_GLA) { pk[0] = 0; pk[1] = 0; }
            *(u32x2*)(OCAT + (size_t)(row0 + t) * D + h * 256 + e) = pk;
        }
    }
}
__device__ __forceinline__ void phase_gla_c(const Params& p, LAS unsigned char* lds) {
    for (int it = blockIdx.x; it < 512; it += gridDim.x) { gla_c_item(p, lds, it); __syncthreads(); }
}

__device__ __forceinline__ void run_gemm_gate(const Params& p, LAS unsigned char* lds, bool first) {
    unsigned char* ws = p.ws;
    Gemm g; g.A = (const bf16_t*)(ws + WS_ACT); g.Bt = (const bf16_t*)(ws + (first ? WS_WT1 : WS_WT5)); g.M = first ? MT : TL; g.N = NFF; g.K = D;
    Order S; S.init(g.M / BM, NFF / BM, gridDim.x, blockIdx.x, 0, D / BK);
    EpiGate E; E.H = (bf16_t*)(ws + WS_HID);
    gemm_phase(lds, g, S, E);
}
template <int WHICH>
__device__ __forceinline__ void run_gemm_resid(const Params& p, LAS unsigned char* lds) {
    constexpr int which = WHICH;
    unsigned char* ws = p.ws;
    float* H1 = (float*)(ws + WS_H1);
    Gemm g; EpiResid<(WHICH == 2 ? 2 : 1)> E; E.mod = (const float*)(ws + WS_MOD); E.out = H1; E.part = (float*)(ws + WS_PART);
    E.st.xbuf = (unsigned*)(ws + WS_XB); E.st.cnt = (unsigned*)(ws + WS_CNT) + which * 32 * 64; E.gain = which == 2 ? p.norm_final : (which == 1 ? p.norm_ffn2 : p.norm_mix); E.sh_idx = which == 0 ? 3 : 6; E.sc_idx = which == 0 ? 4 : 7; E.act = (bf16_t*)(ws + WS_ACT); E.fout = p.out;
    if (which == 0) { g.A = (const bf16_t*)(ws + WS_HID); g.Bt = (const bf16_t*)(ws + WS_WT2); g.M = TL; g.K = DFF; E.resid_lat = p.x; E.resid_ctx = p.ctx; E.gidx = 2; E.gs = 0.5f; }
    else if (which == 1) { g.A = (const bf16_t*)(ws + WS_ACT); g.Bt = (const bf16_t*)(ws + WS_WT4); g.M = TL; g.K = D; E.resid_lat = H1; E.resid_ctx = H1; E.gidx = 5; E.gs = 1.0f; }
    else { g.A = (const bf16_t*)(ws + WS_HID); g.Bt = (const bf16_t*)(ws + WS_WT6); g.M = TL; g.K = DFF; E.resid_lat = H1; E.resid_ctx = H1; E.gidx = 8; E.gs = 0.5f; }
    g.N = D;
    Order S; S.init(g.M / BM, D / BM, gridDim.x, blockIdx.x, which == 0 ? 2 : 0, g.K / BK);
    gemm_phase(lds, g, S, E);
}
__device__ __forceinline__ void run_gemm_in(const Params& p, LAS unsigned char* lds) {
    unsigned char* ws = p.ws;
    Gemm g; g.A = (const bf16_t*)(ws + WS_ACT); g.Bt = (const bf16_t*)(ws + WS_WT3); g.M = TL; g.N = N3; g.K = D;
    Order S; S.init(TL / BM, N3 / BM, gridDim.x, blockIdx.x, 1, D / BK);
    EpiIn E; E.PX = (bf16_t*)(ws + WS_PX); E.U = (bf16_t*)(ws + WS_U); E.GK = (float*)(ws + WS_GK);
    gemm_phase(lds, g, S, E);
}


#define XB_TMO      128
#define XB_XCNT(j)  (256  + 64 * (j))
#define XB_XSUB(j)  (1280 + 64 * (j))
#define XB_XGEN(j)  (2304 + 64 * (j))
#define XB_TOP      3328
#define XB_TOPGEN   3392
#define XCD_BAR_WORDS 3456
#define XB_SPIN_CAP (1u << 18)
__device__ __forceinline__ unsigned xb_ld(unsigned* p)              { return __hip_atomic_load(p, __ATOMIC_RELAXED, __HIP_MEMORY_SCOPE_AGENT); }
__device__ __forceinline__ unsigned xb_add(unsigned* p, unsigned v) { return __hip_atomic_fetch_add(p, v, __ATOMIC_RELAXED, __HIP_MEMORY_SCOPE_AGENT); }
__device__ __forceinline__ unsigned xb_xcc_id() { return (unsigned)__builtin_amdgcn_s_getreg((3 << 11) | 20) & 0xFu; }
#define XB_SPIN(cond, bar) do { unsigned _sp = 0; while (cond) { __builtin_amdgcn_s_sleep(1); \
    if ((++_sp & 255u) == 0u) { if (xb_ld(&(bar)[XB_TMO])) break; if (_sp > XB_SPIN_CAP) { atomicAdd(&(bar)[XB_TMO], 1u); break; } } } } while (0)
struct XcdBarrier { unsigned* bar; unsigned x; volatile LAS unsigned* st; };
__device__ __forceinline__ XcdBarrier xcd_barrier_post(unsigned* bar, volatile LAS unsigned* st) {
    XcdBarrier b; b.bar = bar; b.x = xb_xcc_id(); b.st = st;
    if (threadIdx.x == 0) (void)xb_add(&bar[XB_XCNT(b.x)], 1u);
    return b;
}
__device__ __forceinline__ void xcd_barrier_complete(unsigned* bar, unsigned x, unsigned& nloc, unsigned& nx) {
    const unsigned G = gridDim.x * gridDim.y * gridDim.z;
    unsigned sum, cnt, mine, sp = 0u;
    for (;;) {
        sum = 0u; cnt = 0u; mine = 0u;
#pragma unroll
        for (unsigned j = 0; j < 16; ++j) { const unsigned c = xb_ld(&bar[XB_XCNT(j)]); sum += c; cnt += (c > 0u) ? 1u : 0u; mine = (j == x) ? c : mine; }
        if (sum == G) break;
        __builtin_amdgcn_s_sleep(1);
        if ((++sp & 255u) == 0u) { if (xb_ld(&bar[XB_TMO])) break; if (sp > XB_SPIN_CAP) { atomicAdd(&bar[XB_TMO], 1u); break; } }
    }
    nloc = mine > 0u ? mine : 1u; nx = cnt > 0u ? cnt : 1u;
}
__device__ __forceinline__ void xcd_barrier(const XcdBarrier& b) {
    asm volatile("s_waitcnt vmcnt(0)" ::: "memory");
    __syncthreads();
    if (threadIdx.x == 0) {
        unsigned* bar = b.bar;
        __builtin_amdgcn_s_waitcnt(0);
        unsigned nloc = b.st[0], nx = b.st[1];
        if (nloc == 0u) { xcd_barrier_complete(bar, b.x, nloc, nx); b.st[0] = nloc; b.st[1] = nx; }
        const unsigned old = xb_add(&bar[XB_XSUB(b.x)], 1u);
        const unsigned gen = old / nloc;
        if (old + 1u == (gen + 1u) * nloc) {
            __builtin_amdgcn_fence(__ATOMIC_RELEASE, "agent");
            asm volatile("s_waitcnt vmcnt(0)" ::: "memory");
            const unsigned og = xb_add(&bar[XB_TOP], 1u);
            const unsigned tg = og / nx;
            if (og + 1u == (tg + 1u) * nx) xb_add(&bar[XB_TOPGEN], 1u);
            else XB_SPIN(xb_ld(&bar[XB_TOPGEN]) == tg, bar);
            __builtin_amdgcn_fence(__ATOMIC_ACQUIRE, "agent");
            xb_add(&bar[XB_XGEN(b.x)], 1u);
            asm volatile("s_waitcnt vmcnt(0)" ::: "memory");
        } else {
            XB_SPIN(xb_ld(&bar[XB_XGEN(b.x)]) == gen, bar);
            __builtin_amdgcn_fence(__ATOMIC_ACQUIRE, "agent");
            asm volatile("s_waitcnt vmcnt(0)" ::: "memory");
        }
    }
    __syncthreads();
}

__device__ __forceinline__ void grid_barrier(cg::grid_group& grid) {
    asm volatile("s_waitcnt vmcnt(0)" ::: "memory");
    __syncthreads();
    grid.sync();
    __builtin_amdgcn_fence(__ATOMIC_ACQUIRE, "agent");
    asm volatile("s_waitcnt vmcnt(0)" ::: "memory");
    __syncthreads();
}
#ifndef DBG_AFTER
#define DBG_AFTER -1
#endif
#ifndef DBG_OFF
#define DBG_OFF WS_HID
#endif
#ifndef DBG_F32
#define DBG_F32 0
#endif
__device__ __forceinline__ void dbg_dump(const Params& p) {
    const size_t n = (size_t)TL * D;
    for (size_t i = (size_t)blockIdx.x * 512 + threadIdx.x; i < n; i += (size_t)gridDim.x * 512) {
        float v;
        if (DBG_F32) v = ((const float*)(p.ws + DBG_OFF))[i]; else v = bf_lo(((const bf16_t*)(p.ws + DBG_OFF))[i]);
        if (!(fabsf(v) < 1e30f)) v = 777.f;
        p.out[i] = v;
    }
}
#define PHASE(n, body) do { if (ph_lo <= (n) && (n) < ph_hi) { if constexpr (((REP_MASK) >> (n)) & 1) { body; xcd_barrier(xb); } if constexpr (PH_ON(n)) { body; } if ((n) + 1 < ph_hi && (n) != 12) { if ((n) == 0) grid_barrier(grid); else xcd_barrier(xb); } if ((n) == DBG_AFTER) { dbg_dump(p); return; } } } while (0)
__global__ void __launch_bounds__(512, 2) mega(Params p, int ph_lo, int ph_hi) {
    extern __shared__ __attribute__((aligned(16))) unsigned char shm[];
    LAS unsigned char* lds = (LAS unsigned char*)shm;
    cg::grid_group grid = cg::this_grid();
    volatile LAS unsigned* xst = (volatile LAS unsigned*)(lds + LDS_BYTES - 16);
    if (threadIdx.x == 0) { xst[0] = 0u; xst[1] = 0u; }
    __syncthreads();
    if (blockIdx.x == 0) { unsigned* zw = (unsigned*)(p.ws + WS_BAR); for (int i = threadIdx.x; i < (int)(WS_ZERO_BYTES / 4); i += 512) zw[i] = 0u; }
    XcdBarrier xb; xb.bar = (unsigned*)(p.ws + WS_BAR); xb.x = xb_xcc_id(); xb.st = xst;
    PHASE(0, phase_prep_weights(p, lds));
    if (threadIdx.x == 0) (void)xb_add(&xb.bar[XB_XCNT(xb.x)], 1u);
    PHASE(1, phase_modnorm<0>(p, 0, MT, p.norm_ffn1, 0, 1));
    PHASE(2, (run_gemm_gate(p, lds, true), wconv_tail(p, lds, 34 * 44, 1408, 2112)));
    PHASE(3, run_gemm_resid<0>(p, lds));
    PHASE(4, phase_ctxnorm(p, lds));
    PHASE(5, (run_gemm_in(p, lds), wconv_tail(p, lds, 686, 2784, 4448)));
    PHASE(6, phase_gla_a_conv(p, lds));
    PHASE(7, phase_scan(p));
    PHASE(8, phase_gla_c(p, lds));
    PHASE(9, run_gemm_resid<1>(p, lds));
    PHASE(11, (run_gemm_gate(p, lds, false), wconv_tail(p, lds, 32 * 44, 4448, 5152)));
    PHASE(12, run_gemm_resid<2>(p, lds));
}

extern "C" void kernel_launch(void* const* d_in, const int* in_sizes, int n_in, void* d_out, int out_size, void* d_ws, size_t ws_size, hipStream_t stream) {
    static int grid_blocks = 0;
    if (grid_blocks == 0) {
        if (ws_size < WS_END) { fprintf(stderr, "kernel_launch: workspace too small: %zu < %zu\n", ws_size, (size_t)WS_END); grid_blocks = -1; return; }
        int dev = 0, cus = 0, per_cu = 0;
        hipGetDevice(&dev);
        hipDeviceGetAttribute(&cus, hipDeviceAttributeMultiprocessorCount, dev);
        if (hipFuncSetAttribute((const void*)mega, hipFuncAttributeMaxDynamicSharedMemorySize, LDS_BYTES) != hipSuccess) { fprintf(stderr, "kernel_launch: hipFuncSetAttribute failed\n"); }
        if (hipOccupancyMaxActiveBlocksPerMultiprocessor(&per_cu, (const void*)mega, 512, LDS_BYTES) != hipSuccess || per_cu < 1) { fprintf(stderr, "kernel_launch: occupancy query gave %d\n", per_cu); per_cu = 1; }
        (void)hipGetLastError();
        if (per_cu > 1) per_cu = 1;
        grid_blocks = cus * per_cu;
        if (grid_blocks != 256) { fprintf(stderr, "kernel_launch: built for 256 workgroups (256 CUs x 1); got %d: nothing launched\n", grid_blocks); grid_blocks = -1; return; }
        fprintf(stderr, "kernel_launch: grid %d blocks (cus %d)\n", grid_blocks, cus);
    }
    if (grid_blocks < 0) return;
    Params p{};
    const float* const* in = (const float* const*)d_in;
    p.x = in[0]; p.c = in[1]; p.ctx = in[2]; p.c_ctx = in[3]; p.w_mod = in[4]; p.b_mod = in[5]; p.norm_ffn1 = in[6]; p.w_ffn1_in = in[7]; p.w_ffn1_out = in[8];
    p.norm_mix = in[9]; p.w_in = in[10]; p.w_gk2 = in[11]; p.b_gk2 = in[12]; p.gla_norm = in[13]; p.conv_w = in[14]; p.conv_b = in[15]; p.conv_ln_g = in[16];
    p.conv_ln_b = in[17]; p.w_out = in[18]; p.norm_ffn2 = in[19]; p.w_ffn2_in = in[20]; p.w_ffn2_out = in[21]; p.norm_final = in[22];
    p.out = (float*)d_out; p.ws = (unsigned char*)d_ws;
    int ph_lo = 0, ph_hi = NPHASE;
    void* args[] = {&p, &ph_lo, &ph_hi};
    hipError_t e = hipLaunchCooperativeKernel((const void*)mega, dim3(grid_blocks), dim3(512), args, LDS_BYTES, stream);
    if (e != hipSuccess) fprintf(stderr, "kernel_launch: cooperative launch failed: %s (grid %d)\n", hipGetErrorString(e), grid_blocks);
}
```

```cpp
#include <hip/hip_runtime.h>
#include <hip/hip_cooperative_groups.h>
#include <cstdio>
namespace cg = cooperative_groups;

#define LAS __attribute__((address_space(3)))
typedef unsigned short bf16_t;
typedef short bf16x8 __attribute__((ext_vector_type(8)));
typedef float f32x4 __attribute__((ext_vector_type(4)));
typedef float f32x2 __attribute__((ext_vector_type(2)));
typedef unsigned u32x4 __attribute__((ext_vector_type(4)));
typedef unsigned u32x2 __attribute__((ext_vector_type(2)));

constexpr int D = 2048, TL = 8192, TCX = 512, MT = 8704, DFF = 5632, NFF = 11264, NIN = 5152, N3 = 5376, PXW = 3072, NMOD = 18432;
constexpr int NSLOT = 68;
constexpr int LDS_BYTES = 147456;
constexpr int NPHASE = 14;
#ifndef PH_MASK
#define PH_MASK 0x3fff
#endif
#define PH_ON(n) (((PH_MASK) >> (n)) & 1)
#ifndef REP_MASK
#define REP_MASK 0
#endif
#ifndef DBG_ZERO_GLA
#define DBG_ZERO_GLA 0
#endif
#ifndef DBG_ZERO_CONV
#define DBG_ZERO_CONV 0
#endif

constexpr size_t al256(size_t x) { return (x + 255) & ~(size_t)255; }
constexpr size_t WS_WT1 = 0;
constexpr size_t WS_WT2 = WS_WT1 + al256((size_t)NFF * D * 2);
constexpr size_t WS_WT3 = WS_WT2 + al256((size_t)D * DFF * 2);
constexpr size_t WS_WT4 = WS_WT3 + al256((size_t)N3 * D * 2);
constexpr size_t WS_WT5 = WS_WT4 + al256((size_t)D * D * 2);
constexpr size_t WS_WT6 = WS_WT5 + al256((size_t)NFF * D * 2);
constexpr size_t WS_MOD = WS_WT6 + al256((size_t)D * DFF * 2);
constexpr size_t WS_ACT = WS_MOD + al256((size_t)3 * NMOD * 4);
constexpr size_t WS_HID = WS_ACT + al256((size_t)MT * D * 2);
constexpr size_t WS_H1 = WS_HID + al256((size_t)MT * DFF * 2);
constexpr size_t WS_PX = WS_H1 + al256((size_t)MT * D * 4);
constexpr size_t WS_U = WS_PX + al256((size_t)MT * PXW * 2);
constexpr size_t WS_GK = WS_U + al256((size_t)TL * 1024 * 2);
constexpr size_t WS_DEC = WS_GK + al256((size_t)MT * 32 * 4);
constexpr size_t WS_PART = WS_DEC + al256((size_t)2 * 8 * NSLOT * 128 * 4);
constexpr size_t WS_BAR = WS_PART + al256((size_t)11 * TCX * D * 4);
constexpr size_t WS_CNT = WS_BAR + 16384;
constexpr size_t WS_XB = WS_CNT + 3 * 32 * 256;
constexpr size_t WS_BC = WS_XB + al256((size_t)TL * 8 * 4);
constexpr size_t WS_VT = WS_BC + (size_t)2 * 8 * 64 * 64 * 128 * 4;
constexpr size_t WS_END = WS_VT + (size_t)8 * 64 * 256 * 64 * 2;
constexpr size_t WS_ZERO_BYTES = 16384 + 3 * 32 * 256;

struct Params {
    const float* x; const float* c; const float* ctx; const float* c_ctx; const float* w_mod; const float* b_mod;
    const float* norm_ffn1; const float* w_ffn1_in; const float* w_ffn1_out; const float* norm_mix; const float* w_in;
    const float* w_gk2; const float* b_gk2; const float* gla_norm; const float* conv_w; const float* conv_b;
    const float* conv_ln_g; const float* conv_ln_b; const float* w_out; const float* norm_ffn2; const float* w_ffn2_in;
    const float* w_ffn2_out; const float* norm_final;
    float* out; unsigned char* ws;
};

typedef __bf16 bf16x2_t __attribute__((ext_vector_type(2)));
__device__ __forceinline__ unsigned cvt_pk_bf16(float lo, float hi) { f32x2 f = {lo, hi}; bf16x2_t v = __builtin_convertvector(f, bf16x2_t); return __builtin_bit_cast(unsigned, v); }
__device__ __forceinline__ float bf_lo(unsigned u) { return __uint_as_float(u << 16); }
__device__ __forceinline__ float bf_hi(unsigned u) { return __uint_as_float(u & 0xffff0000u); }
__device__ __forceinline__ float wave_sum(float v) {
#pragma unroll
    for (int o = 32; o >= 1; o >>= 1) v += __shfl_xor(v, o, 64);
    return v;
}
__device__ __forceinline__ float silu_f(float x) { return x * __builtin_amdgcn_rcpf(1.f + __expf(-x)); }
__device__ __forceinline__ float sigmoid_f(float x) { return __builtin_amdgcn_rcpf(1.f + __expf(-x)); }
__device__ __forceinline__ int otid() { int t = threadIdx.x; asm volatile("" : "+v"(t)); return t; }
__host__ __device__ __forceinline__ int perm32(int rho) { const int n = rho >> 4, i = rho & 15; return 8 * (i >> 2) + 4 * n + (i & 3); }

constexpr int BM = 256, BK = 64, HALF = 128, HTB = HALF * BK * 2, NXCD = 8, WGM = 4;
__device__ __forceinline__ int lds_byte(int r, int c) { const int st = (r >> 4) * 2 + (c >> 5), rr = r & 15, cc = c & 31, ob = rr * 64 + cc * 2; return st * 1024 + (ob ^ (((ob >> 9) & 1) << 5)); }
__device__ __forceinline__ void stage_rc(int b, int& R, int& C) { const int st = b / 1024, sb = b % 1024, swz = sb ^ (((sb >> 9) & 1) << 5); R = (st >> 1) * 16 + swz / 64; C = (st & 1) * 32 + (swz % 64) / 2; }

struct Unit { int pm, pn, kt0, nt; };
struct Gemm { const bf16_t* A; const bf16_t* Bt; int M, N, K; };
struct Order {
    int nM, nN, nwg, G, c, extra, mode, ntk;
    __device__ void init(int nM_, int nN_, int G_, int c_, int mode_, int ntk_) { nM = nM_; nN = nN_; nwg = nM * nN; G = G_; c = c_; mode = mode_; ntk = ntk_; extra = mode == 1 ? 14 : 0; }
    __device__ bool next(int i, Unit& u) const {
        long L = (long)i * G + c;
        u.kt0 = 0; u.nt = ntk;
        if (mode == 2) {
            const bool has_small = c < 176;
            if (has_small && i == 0) { const int idx = c; u.pm = nM + idx / 88; const int rem = idx % 88; u.pn = rem / 11; u.kt0 = (rem % 11) * 8; u.nt = 8; return true; }
            if ((has_small ? i - 1 : i) != 0) return false;
            L = c;
        }
        if (L >= nwg + extra) return false;
        if (L >= nwg) {
            const int idx = (int)L - nwg;
            if (mode == 1) { u.pm = nM + idx / 7; const int q = idx % 7; u.pn = q < 6 ? q : 20; }
            else return false;
            return true;
        }
        int wgid = (int)L; { const int q = nwg / NXCD, r = nwg % NXCD, xcd = wgid % NXCD, off = wgid / NXCD; wgid = (xcd < r ? xcd * (q + 1) : r * (q + 1) + (xcd - r) * q) + off; }
        const int nig = WGM * nN, gid = wgid / nig, fm = gid * WGM, gsz = (nM - fm) < WGM ? (nM - fm) : WGM;
        u.pm = fm + ((wgid % nig) % gsz); u.pn = (wgid % nig) / gsz; return true;
    }
};


constexpr int L_RS_P = 131072, L_RS_S = 131072 + 4096;
struct RowStats {
    unsigned* xbuf; unsigned* cnt;
    __device__ __forceinline__ void run(const f32x4 (&v)[2][2][4][2], const Unit& u, int wr, int wc, int fr, int fq, LAS unsigned char* lds, int wid, int lane) const {
        LAS float* P = (LAS float*)(lds + L_RS_P);
        LAS float* S = (LAS float*)(lds + L_RS_S);
#pragma unroll
        for (int ai = 0; ai < 2; ++ai)
#pragma unroll
            for (int m = 0; m < 4; ++m) {
                float q = 0.f;
#pragma unroll
                for (int bj = 0; bj < 2; ++bj)
#pragma unroll
                    for (int n = 0; n < 2; ++n) { const f32x4 x = v[ai][bj][m][n]; q += (x[0] * x[0] + x[1] * x[1]) + (x[2] * x[2] + x[3] * x[3]); }
                q += __shfl_xor(q, 16, 64); q += __shfl_xor(q, 32, 64);
                if (fq == 0) P[(ai * HALF + wr * 64 + m * 16 + fr) * 4 + wc] = q;
            }
        __syncthreads();
        const int row = wid * 32 + (lane & 31);
        if (lane < 32) {
            const float tot = (P[row * 4 + 0] + P[row * 4 + 1]) + (P[row * 4 + 2] + P[row * 4 + 3]);
            __hip_atomic_store(xbuf + (size_t)(u.pm * BM + row) * 8 + u.pn, __float_as_uint(tot), __ATOMIC_RELAXED, __HIP_MEMORY_SCOPE_AGENT);
        }
        asm volatile("s_waitcnt vmcnt(0)" ::: "memory");
        if (lane == 0) __hip_atomic_fetch_add(cnt + 64 * u.pm, 1u, __ATOMIC_RELAXED, __HIP_MEMORY_SCOPE_AGENT);
        if (wid == 0) {
            unsigned spins = 0;
            while ((unsigned)__builtin_amdgcn_readfirstlane(__hip_atomic_load(cnt + 64 * u.pm, __ATOMIC_RELAXED, __HIP_MEMORY_SCOPE_AGENT)) < 64u) {
                __builtin_amdgcn_s_sleep(2);
                if (++spins > (1u << 22)) break;
            }
            __builtin_amdgcn_fence(__ATOMIC_ACQUIRE, "agent");
        }
        asm volatile("s_waitcnt vmcnt(0) lgkmcnt(0)" ::: "memory");
        __syncthreads();
        if (lane < 32) {
            const unsigned* slot = xbuf + (size_t)(u.pm * BM + row) * 8; float tot = 0.f;
#pragma unroll
            for (int t = 0; t < 8; ++t) tot += __uint_as_float(__hip_atomic_load(slot + t, __ATOMIC_RELAXED, __HIP_MEMORY_SCOPE_AGENT));
            S[row] = rsqrtf(tot * (1.f / 2048.f) + 1e-6f);
        }
        __syncthreads();
    }
};

struct EpiGate {
    bf16_t* H;
    __device__ __forceinline__ bool defer(const Unit&) const { return false; }
    __device__ __forceinline__ void fused(f32x4 (&)[2][2][4][2], const Unit&, int, int, int, int, LAS unsigned char*, int, int) const {}
    __device__ __forceinline__ void operator()(const f32x4 (&acc)[2][2][4][2], const Unit& u, int wr, int wc, int fr, int fq) const {
        const int row0 = u.pm * BM + wr * 64 + fr, col0 = u.pn * 128 + wc * 32 + 8 * fq;
#pragma unroll
        for (int ai = 0; ai < 2; ++ai)
#pragma unroll
            for (int m = 0; m < 4; ++m) {
                float o[8];
#pragma unroll
                for (int n = 0; n < 2; ++n)
#pragma unroll
                    for (int i = 0; i < 4; ++i) o[n * 4 + i] = silu_f(acc[ai][0][m][n][i]) * acc[ai][1][m][n][i];
                u32x4 pk; pk[0] = cvt_pk_bf16(o[0], o[1]); pk[1] = cvt_pk_bf16(o[2], o[3]); pk[2] = cvt_pk_bf16(o[4], o[5]); pk[3] = cvt_pk_bf16(o[6], o[7]);
                *(u32x4*)(H + (size_t)(row0 + ai * HALF + m * 16) * DFF + col0) = pk;
            }
    }
};
template <int FMODE> struct EpiResid {
    const float* resid_lat; const float* resid_ctx; float* out; const float* mod; int gidx; float gs; float* part;
    RowStats st; const float* gain; int sh_idx, sc_idx; bf16_t* act; float* fout;
    __device__ __forceinline__ bool defer(const Unit& u) const { return FMODE != 0 && u.pm < TL / BM; }
    __device__ __forceinline__ void fused(f32x4 (&acc)[2][2][4][2], const Unit& u, int wr, int wc, int fr, int fq, LAS unsigned char* lds, int wid, int lane) const {
        const int rowt = u.pm * BM; const int set = rowt < 4096 ? 0 : 1;
        const float* md = mod + (size_t)set * NMOD;
        const int row0 = rowt + wr * 64 + fr, col0 = u.pn * BM + wc * 32 + 4 * fq;
        {
            f32x4 gv[2][2];
#pragma unroll
            for (int bj = 0; bj < 2; ++bj)
#pragma unroll
                for (int n = 0; n < 2; ++n) gv[bj][n] = *(const f32x4*)(md + gidx * D + col0 + bj * HALF + n * 16) * gs;
#pragma unroll
            for (int ai = 0; ai < 2; ++ai)
#pragma unroll
                for (int m = 0; m < 4; ++m) {
                    const size_t ro = (size_t)(row0 + ai * HALF + m * 16) * D + col0;
#pragma unroll
                    for (int bj = 0; bj < 2; ++bj)
#pragma unroll
                        for (int n = 0; n < 2; ++n) acc[ai][bj][m][n] = *(const f32x4*)(resid_lat + ro + bj * HALF + n * 16) + gv[bj][n] * acc[ai][bj][m][n];
                    asm volatile("" : "+v"(acc[ai][0][m][0]), "+v"(acc[ai][0][m][1]), "+v"(acc[ai][1][m][0]), "+v"(acc[ai][1][m][1]));
                    if (m & 1) asm volatile("" ::: "memory");
                }
        }
        st.run(acc, u, wr, wc, fr, fq, lds, wid, lane);
        const LAS float* S = (const LAS float*)(lds + L_RS_S);
        f32x4 g2[2][2], sh[2][2];
#pragma unroll
        for (int bj = 0; bj < 2; ++bj)
#pragma unroll
            for (int n = 0; n < 2; ++n) {
                const int c = col0 + bj * HALF + n * 16;
                g2[bj][n] = *(const f32x4*)(gain + c);
                if (FMODE == 1) { g2[bj][n] *= (*(const f32x4*)(md + sc_idx * D + c) + 1.f); sh[bj][n] = *(const f32x4*)(md + sh_idx * D + c); }
                else sh[bj][n] = (f32x4){0.f, 0.f, 0.f, 0.f};
            }
#pragma unroll
        for (int ai = 0; ai < 2; ++ai)
#pragma unroll
            for (int m = 0; m < 4; ++m) {
                const int r = ai * HALF + wr * 64 + m * 16 + fr; const float rs = S[r];
                const size_t ro = (size_t)(rowt + r) * D + col0;
#pragma unroll
                for (int bj = 0; bj < 2; ++bj)
#pragma unroll
                    for (int n = 0; n < 2; ++n) {
                        const f32x4 h = acc[ai][bj][m][n];
                        const f32x4 o = h * rs * g2[bj][n] + sh[bj][n];
                        if (FMODE == 1) {
                            *(f32x4*)(out + ro + bj * HALF + n * 16) = h;
                            u32x2 pk; pk[0] = cvt_pk_bf16(o[0], o[1]); pk[1] = cvt_pk_bf16(o[2], o[3]);
                            *(u32x2*)(act + ro + bj * HALF + n * 16) = pk;
                        } else *(f32x4*)(fout + ro + bj * HALF + n * 16) = o;
                    }
                asm volatile("" ::: "memory");
            }
    }
    __device__ __forceinline__ void operator()(const f32x4 (&acc)[2][2][4][2], const Unit& u, int wr, int wc, int fr, int fq) const {
        if (u.pm >= TL / BM) {
            float* pb = part + (size_t)(u.kt0 >> 3) * TCX * D;
            const int row0 = u.pm * BM - TL + wr * 64 + fr, col0 = u.pn * BM + wc * 32 + 4 * fq;
#pragma unroll
            for (int ai = 0; ai < 2; ++ai)
#pragma unroll
                for (int m = 0; m < 4; ++m)
#pragma unroll
                    for (int bj = 0; bj < 2; ++bj)
#pragma unroll
                        for (int n = 0; n < 2; ++n) *(f32x4*)(pb + (size_t)(row0 + ai * HALF + m * 16) * D + col0 + bj * HALF + n * 16) = acc[ai][bj][m][n];
            return;
        }
        const int rowt = u.pm * BM; const int set = rowt < 4096 ? 0 : (rowt < 8192 ? 1 : 2);
        const float* rb = rowt < TL ? resid_lat : (resid_ctx - (size_t)TL * D);
        const float* mg = mod + (size_t)set * NMOD + gidx * D;
        const int row0 = rowt + wr * 64 + fr, col0 = u.pn * BM + wc * 32 + 4 * fq;
        f32x4 gv[2][2];
#pragma unroll
        for (int bj = 0; bj < 2; ++bj)
#pragma unroll
            for (int n = 0; n < 2; ++n) gv[bj][n] = *(const f32x4*)(mg + col0 + bj * HALF + n * 16) * gs;
#pragma unroll
        for (int ai = 0; ai < 2; ++ai)
#pragma unroll
            for (int m = 0; m < 4; ++m) {
                const size_t ro = (size_t)(row0 + ai * HALF + m * 16) * D + col0;
#pragma unroll
                for (int bj = 0; bj < 2; ++bj)
#pragma unroll
                    for (int n = 0; n < 2; ++n) {
                        const f32x4 r = *(const f32x4*)(rb + ro + bj * HALF + n * 16);
                        *(f32x4*)(out + ro + bj * HALF + n * 16) = r + gv[bj][n] * acc[ai][bj][m][n];
                    }
            }
    }
};
struct EpiIn {
    bf16_t* PX; bf16_t* U; float* GK;
    __device__ __forceinline__ bool defer(const Unit&) const { return false; }
    __device__ __forceinline__ void fused(f32x4 (&)[2][2][4][2], const Unit&, int, int, int, int, LAS unsigned char*, int, int) const {}
    __device__ __forceinline__ void operator()(const f32x4 (&acc)[2][2][4][2], const Unit& u, int wr, int wc, int fr, int fq) const {
        const int row0 = u.pm * BM + wr * 64 + fr;
        if (u.pn < 12) {
            const int col0 = u.pn * BM + wc * 32 + 8 * fq;
#pragma unroll
            for (int ai = 0; ai < 2; ++ai)
#pragma unroll
                for (int m = 0; m < 4; ++m)
#pragma unroll
                    for (int bj = 0; bj < 2; ++bj) {
                        const f32x4 a = acc[ai][bj][m][0], b = acc[ai][bj][m][1];
                        u32x4 pk; pk[0] = cvt_pk_bf16(a[0], a[1]); pk[1] = cvt_pk_bf16(a[2], a[3]); pk[2] = cvt_pk_bf16(b[0], b[1]); pk[3] = cvt_pk_bf16(b[2], b[3]);
                        *(u32x4*)(PX + (size_t)(row0 + ai * HALF + m * 16) * PXW + col0 + bj * HALF) = pk;
                    }
        } else if (u.pn < 20) {
            const int col0 = (u.pn - 12) * 128 + wc * 32 + 8 * fq;
#pragma unroll
            for (int ai = 0; ai < 2; ++ai)
#pragma unroll
                for (int m = 0; m < 4; ++m) {
                    float o[8];
#pragma unroll
                    for (int n = 0; n < 2; ++n)
#pragma unroll
                        for (int i = 0; i < 4; ++i) o[n * 4 + i] = acc[ai][0][m][n][i] * sigmoid_f(acc[ai][1][m][n][i]);
                    u32x4 pk; pk[0] = cvt_pk_bf16(o[0], o[1]); pk[1] = cvt_pk_bf16(o[2], o[3]); pk[2] = cvt_pk_bf16(o[4], o[5]); pk[3] = cvt_pk_bf16(o[6], o[7]);
                    *(u32x4*)(U + (size_t)(row0 + ai * HALF + m * 16) * 1024 + col0) = pk;
                }
        } else {
            if (wc == 0) {
#pragma unroll
                for (int ai = 0; ai < 2; ++ai)
#pragma unroll
                    for (int m = 0; m < 4; ++m)
#pragma unroll
                        for (int n = 0; n < 2; ++n) *(f32x4*)(GK + (size_t)(row0 + ai * HALF + m * 16) * 32 + n * 16 + 4 * fq) = acc[ai][0][m][n];
            }
        }
    }
};

template <class Epi>
__device__ __forceinline__ void gemm_phase(LAS unsigned char* lds, const Gemm g, const Order& S, const Epi& E) {
    const int tid = otid(), wid = __builtin_amdgcn_readfirstlane(tid >> 6), lane = tid & 63, wr = wid >> 2, wc = wid & 3, fr = lane & 15, fq = lane >> 4;
    const int K = g.K;
    unsigned voffA[2];
#pragma unroll
    for (int i = 0; i < 2; ++i) { int R, C; stage_rc(tid * 16 + i * 8192, R, C); voffA[i] = (unsigned)(R * K + C) * 2u; }
    const size_t kstep = (size_t)(BK * 2);
    const size_t hstep = (size_t)HALF * K * 2;
    const size_t tstep = 2 * hstep;
    const unsigned ldsw = (unsigned)wid * 1024u;
    const int aoff = lds_byte(wr * 64 + fr, fq * 8), boff = lds_byte(wc * 32 + fr, fq * 8);
#define PG8_SA(b, h) (((b) * 2 + (h)) * HTB)
#define PG8_SB(b, h) ((4 + (b) * 2 + (h)) * HTB)
#define PG8_STAGE(bufoff, gbase) do { _Pragma("unroll") for (int _i = 0; _i < 2; ++_i) \
        __builtin_amdgcn_global_load_lds((const unsigned*)((const char*)(gbase) + voffA[_i]), (LAS unsigned*)(lds + (bufoff) + ldsw + _i * 8192), 16, 0, 0); } while (0)
#define PG8_LDA(dst, b, h) do { _Pragma("unroll") for (int m = 0; m < 4; ++m) _Pragma("unroll") for (int k = 0; k < 2; ++k) dst[m][k] = *(const LAS bf16x8*)(lds + PG8_SA(b, h) + aoff + m * 2048 + k * 1024); } while (0)
#define PG8_LDB(dst, b, h) do { _Pragma("unroll") for (int n = 0; n < 2; ++n) _Pragma("unroll") for (int k = 0; k < 2; ++k) dst[n][k] = *(const LAS bf16x8*)(lds + PG8_SB(b, h) + boff + n * 2048 + k * 1024); } while (0)
#define PG8_MMA(ai, bj, At, Bt) do { __builtin_amdgcn_s_setprio(1); _Pragma("unroll") for (int m = 0; m < 4; ++m) _Pragma("unroll") for (int n = 0; n < 2; ++n) _Pragma("unroll") for (int k = 0; k < 2; ++k) \
        acc[ai][bj][m][n] = __builtin_amdgcn_mfma_f32_16x16x32_bf16(Bt[n][k], At[m][k], acc[ai][bj][m][n], 0, 0, 0); __builtin_amdgcn_s_setprio(0); } while (0)
#define PG8_WAIT_V(n) asm volatile("s_waitcnt vmcnt(" #n ")" ::: "memory")
#define PG8_WAIT_L(n) asm volatile("s_waitcnt lgkmcnt(" #n ")" ::: "memory")
#define PG8_BAR __builtin_amdgcn_s_barrier()
#define PG8_SCHED __builtin_amdgcn_sched_barrier(0)
    Unit cur, nxt; int ui = 0;
    if (!S.next(0, cur)) return;
    f32x4 acc[2][2][4][2];
#pragma unroll
    for (int a = 0; a < 2; ++a)
#pragma unroll
        for (int b = 0; b < 2; ++b)
#pragma unroll
            for (int m = 0; m < 4; ++m)
#pragma unroll
                for (int n = 0; n < 2; ++n) acc[a][b][m][n] = (f32x4){0.f, 0.f, 0.f, 0.f};
    bf16x8 At[4][2], B0[2][2], B1[2][2];
    const char* cA = (const char*)g.A + (size_t)cur.pm * tstep + (size_t)cur.kt0 * kstep; const char* cB = (const char*)g.Bt + (size_t)cur.pn * tstep + (size_t)cur.kt0 * kstep;
    PG8_STAGE(PG8_SB(0, 0), cB); PG8_STAGE(PG8_SA(0, 0), cA); PG8_STAGE(PG8_SB(0, 1), cB + hstep); PG8_STAGE(PG8_SA(0, 1), cA + hstep);
    if (wr == 1) PG8_BAR;
    PG8_WAIT_V(4); PG8_BAR;
    PG8_STAGE(PG8_SB(1, 0), cB + kstep); PG8_STAGE(PG8_SA(1, 0), cA + kstep); PG8_STAGE(PG8_SB(1, 1), cB + hstep + kstep);
    PG8_WAIT_V(6); PG8_BAR;
    for (;;) {
        const bool has_next = S.next(ui + 1, nxt);
        const char* nA = has_next ? (const char*)g.A + (size_t)nxt.pm * tstep + (size_t)nxt.kt0 * kstep : cA; const char* nB = has_next ? (const char*)g.Bt + (size_t)nxt.pn * tstep + (size_t)nxt.kt0 * kstep : cB;
        const int nt = cur.nt;
        for (int t = 0; t < nt; t += 2) {
            const bool last = (t == nt - 2);
            const char* a1 = cA + (size_t)(t + 1) * kstep;
            const char* a2 = last ? nA : cA + (size_t)(t + 2) * kstep; const char* b2 = last ? nB : cB + (size_t)(t + 2) * kstep;
            const char* a3 = a2 + kstep; const char* b3 = b2 + kstep;
            PG8_LDB(B0, 0, 0); PG8_SCHED; PG8_LDA(At, 0, 0); PG8_STAGE(PG8_SA(1, 1), a1 + hstep);
            PG8_WAIT_L(8); PG8_BAR; PG8_WAIT_L(0); PG8_MMA(0, 0, At, B0); PG8_BAR; PG8_SCHED;
            PG8_LDB(B1, 0, 1); PG8_STAGE(PG8_SB(0, 0), b2);
            PG8_BAR; PG8_WAIT_L(0); PG8_MMA(0, 1, At, B1); PG8_BAR;
            PG8_LDA(At, 0, 1); PG8_STAGE(PG8_SA(0, 0), a2);
            PG8_BAR; PG8_WAIT_L(0); PG8_MMA(1, 0, At, B0); PG8_BAR; PG8_SCHED;
            PG8_STAGE(PG8_SB(0, 1), b2 + hstep);
            PG8_WAIT_V(6); PG8_BAR; PG8_MMA(1, 1, At, B1); PG8_BAR;
            PG8_LDB(B0, 1, 0); PG8_SCHED; PG8_LDA(At, 1, 0); PG8_STAGE(PG8_SA(0, 1), a2 + hstep);
            PG8_WAIT_L(8); PG8_BAR; PG8_WAIT_L(0); PG8_MMA(0, 0, At, B0); PG8_BAR; PG8_SCHED;
            PG8_LDB(B1, 1, 1); PG8_STAGE(PG8_SB(1, 0), b3);
            PG8_BAR; PG8_WAIT_L(0); PG8_MMA(0, 1, At, B1); PG8_BAR;
            PG8_LDA(At, 1, 1); PG8_STAGE(PG8_SA(1, 0), a3);
            PG8_BAR; PG8_WAIT_L(0); PG8_MMA(1, 0, At, B0); PG8_BAR; PG8_SCHED;
            PG8_STAGE(PG8_SB(1, 1), b3 + hstep);
            PG8_WAIT_V(6); PG8_BAR; PG8_MMA(1, 1, At, B1); PG8_BAR;
        }
        if (!E.defer(cur)) E(acc, cur, wr, wc, fr, fq);
        if (!has_next) break;
#pragma unroll
        for (int a = 0; a < 2; ++a)
#pragma unroll
            for (int b = 0; b < 2; ++b)
#pragma unroll
                for (int m = 0; m < 4; ++m)
#pragma unroll
                    for (int n = 0; n < 2; ++n) acc[a][b][m][n] = (f32x4){0.f, 0.f, 0.f, 0.f};
        cur = nxt; cA = nA; cB = nB; ++ui;
    }
    PG8_WAIT_V(0);
    if (wr == 0) PG8_BAR;
    PG8_BAR;
    if (E.defer(cur)) E.fused(acc, cur, wr, wc, fr, fq, lds, wid, lane);
#undef PG8_SA
#undef PG8_SB
#undef PG8_STAGE
#undef PG8_LDA
#undef PG8_LDB
#undef PG8_MMA
#undef PG8_WAIT_V
#undef PG8_WAIT_L
#undef PG8_BAR
#undef PG8_SCHED
}

__device__ __forceinline__ void gemv_item(const Params& p, LAS unsigned char* lds, int nt) {
    const int tid = otid();
    LAS float* sv = (LAS float*)lds;
    LAS float* red = sv + 3 * 2048;
    {
        float cvv[12];
#pragma unroll
        for (int q = 0; q < 12; ++q) { const int k = (tid + 512 * q) & 2047; cvv[q] = (q >> 2) < 2 ? p.c[(q >> 2) * 2048 + k] : p.c_ctx[k]; }
#pragma unroll
        for (int q = 0; q < 12; ++q) sv[tid + 512 * q] = cvv[q] / (1.f + __expf(-cvv[q]));
    }
    __syncthreads();
    const int cg4 = tid & 31, kl = tid >> 5;
    const float* wp = p.w_mod + (size_t)kl * NMOD + nt * 128 + cg4 * 4;
    f32x4 a0 = {0.f, 0.f, 0.f, 0.f}, a1 = a0, a2 = a0;
#pragma unroll 8
    for (int k = kl; k < 2048; k += 16) {
        const f32x4 w = __builtin_nontemporal_load((const f32x4*)wp); wp += (size_t)16 * NMOD;
        const float s0 = sv[k], s1 = sv[2048 + k], s2 = sv[4096 + k];
        a0 += w * s0; a1 += w * s1; a2 += w * s2;
    }
#pragma unroll
    for (int i = 0; i < 4; ++i) { red[(kl * 3 + 0) * 128 + cg4 * 4 + i] = a0[i]; red[(kl * 3 + 1) * 128 + cg4 * 4 + i] = a1[i]; red[(kl * 3 + 2) * 128 + cg4 * 4 + i] = a2[i]; }
    __syncthreads();
    if (tid < 384) {
        const int r = tid >> 7, col = tid & 127; float s = 0.f;
#pragma unroll
        for (int q = 0; q < 16; ++q) s += red[(q * 3 + r) * 128 + col];
        float* MOD = (float*)(p.ws + WS_MOD);
        MOD[r * NMOD + nt * 128 + col] = s + p.b_mod[nt * 128 + col];
    }
}

struct WcDesc { const float* src; bf16_t* dst; int K, Nsrc, perm, nvalid; };
__device__ __forceinline__ WcDesc wconv_decode(const Params& p, int it) {
    int w, loc;
    if (it < 1408) { w = 0; loc = it; } else if (it < 2112) { w = 1; loc = it - 1408; } else if (it < 2784) { w = 2; loc = it - 2112; }
    else if (it < 3040) { w = 3; loc = it - 2784; } else if (it < 4448) { w = 4; loc = it - 3040; } else { w = 5; loc = it - 4448; }
    const float* src; bf16_t* dst; int K, Nsrc, nR;
    switch (w) {
        case 0: src = p.w_ffn1_in; dst = (bf16_t*)(p.ws + WS_WT1); K = D; Nsrc = NFF; nR = 88; break;
        case 1: src = p.w_ffn1_out; dst = (bf16_t*)(p.ws + WS_WT2); K = DFF; Nsrc = D; nR = 16; break;
        case 2: src = p.w_in; dst = (bf16_t*)(p.ws + WS_WT3); K = D; Nsrc = NIN; nR = 42; break;
        case 3: src = p.w_out; dst = (bf16_t*)(p.ws + WS_WT4); K = D; Nsrc = D; nR = 16; break;
        case 4: src = p.w_ffn2_in; dst = (bf16_t*)(p.ws + WS_WT5); K = D; Nsrc = NFF; nR = 88; break;
        default: src = p.w_ffn2_out; dst = (bf16_t*)(p.ws + WS_WT6); K = DFF; Nsrc = D; nR = 16; break;
    }
    const int R = loc % nR, kt = loc / nR, k0 = kt * 128;
    int sbase, perm, nvalid = 128;
    if (w == 0 || w == 4) { sbase = (R & 1) * DFF + 128 * (R >> 1); perm = 1; }
    else if (w == 2) {
        if (R < 24) { sbase = 128 * R + (R >= 12 ? 32 : 0); perm = 1; }
        else if (R < 40) { const int q = R - 24; sbase = 3104 + (q & 1) * 1024 + 128 * (q >> 1); perm = 1; }
        else if (R == 40) { sbase = 1536; perm = 0; nvalid = 32; }
        else { sbase = 0; perm = 0; nvalid = 0; }
    } else { sbase = 128 * R; perm = 0; }
    WcDesc d; d.src = src + (size_t)k0 * Nsrc + sbase; d.dst = dst + (size_t)(128 * R) * K + k0; d.K = K; d.Nsrc = Nsrc; d.perm = perm; d.nvalid = nvalid;
    return d;
}
__device__ __forceinline__ void wconv_load(const WcDesc& d, int tid, f32x4 (&v)[2][4]) {
    const int cb = tid & 31;
#pragma unroll
    for (int iter = 0; iter < 2; ++iter) {
        const int kb = (tid >> 5) + 16 * iter;
#pragma unroll
        for (int kr = 0; kr < 4; ++kr) {
            if (4 * cb < d.nvalid) v[iter][kr] = __builtin_nontemporal_load((const f32x4*)(d.src + (size_t)(4 * kb + kr) * d.Nsrc + 4 * cb));
            else v[iter][kr] = (f32x4){0.f, 0.f, 0.f, 0.f};
        }
    }
}
__device__ __forceinline__ void wconv_lds(LAS unsigned char* lds, int tid, const f32x4 (&v)[2][4]) {
    const int cb = tid & 31;
#pragma unroll
    for (int iter = 0; iter < 2; ++iter) {
        const int kb = (tid >> 5) + 16 * iter;
#pragma unroll
        for (int ci = 0; ci < 4; ++ci) {
            u32x2 pk; pk[0] = cvt_pk_bf16(v[iter][0][ci], v[iter][1][ci]); pk[1] = cvt_pk_bf16(v[iter][2][ci], v[iter][3][ci]);
            *(LAS u32x2*)(lds + (4 * cb + ci) * 264 + 8 * kb) = pk;
        }
    }
}
__device__ __forceinline__ void wconv_out(const WcDesc& d, LAS unsigned char* lds, int tid) {
#pragma unroll
    for (int iter = 0; iter < 4; ++iter) {
        const int rr = (tid >> 4) + 32 * iter, kg = tid & 15;
        const int cc = d.perm ? ((rr & ~31) + perm32(rr & 31)) : rr;
        const u32x2 lo = *(const LAS u32x2*)(lds + cc * 264 + 16 * kg), hi = *(const LAS u32x2*)(lds + cc * 264 + 16 * kg + 8);
        u32x4 o; o[0] = lo[0]; o[1] = lo[1]; o[2] = hi[0]; o[3] = hi[1];
        *(u32x4*)(d.dst + (size_t)rr * d.K + 8 * kg) = o;
    }
}
template <class MAP>
__device__ __forceinline__ void wconv_run(const Params& p, LAS unsigned char* lds, int first, int stride, int nloc, MAP map) {
    const int tid = otid();
    if (first >= nloc) return;
    f32x4 va[2][4], vb[2][4];
    WcDesc da = wconv_decode(p, map(first)); wconv_load(da, tid, va);
    int itb = first + stride; bool hb = itb < nloc; WcDesc db = da;
    if (hb) { db = wconv_decode(p, map(itb)); wconv_load(db, tid, vb); }
    for (;;) {
        wconv_lds(lds, tid, va);
        __syncthreads();
        const int itc = itb + stride; const bool hc = hb && itc < nloc; WcDesc dc = da;
        if (hc) { dc = wconv_decode(p, map(itc)); wconv_load(dc, tid, va); }
        wconv_out(da, lds, tid);
        __syncthreads();
        if (!hb) break;
        wconv_lds(lds, tid, vb);
        __syncthreads();
        const int itd = itc + stride; const bool hd = hc && itd < nloc; WcDesc dd = db;
        if (hd) { dd = wconv_decode(p, map(itd)); wconv_load(dd, tid, vb); }
        wconv_out(db, lds, tid);
        __syncthreads();
        if (!hc) break;
        da = dc; db = dd; itb = itd; hb = hd;
    }
}

__device__ __forceinline__ void phase_prep_weights(const Params& p, LAS unsigned char* lds) {
    for (int it = blockIdx.x; it < 144; it += gridDim.x) { gemv_item(p, lds, it); __syncthreads(); }
    const int G = gridDim.x; const int c = (int)((blockIdx.x + G - (144 % G)) % G);
    wconv_run(p, lds, c, G, 1408 + 672, [](int i) { return i < 1408 ? i : i - 1408 + 2112; });
}
__device__ __forceinline__ void wconv_tail(const Params& p, LAS unsigned char* lds, int nunits, int it0, int it1) {
    const int G = gridDim.x, first_idle = nunits % G, nidle = G - first_idle, c = blockIdx.x;
    if (c >= first_idle) wconv_run(p, lds, c - first_idle, nidle, it1 - it0, [it0](int i) { return i + it0; });
}

template <int MODE>
__device__ __forceinline__ void phase_modnorm(const Params& p, int row_begin, int nrows, const float* gain, int shift_idx, int scale_idx) {
    const int tid_ = otid(); const int wave = tid_ >> 6, lane = tid_ & 63;
    const float* MOD = (const float*)(p.ws + WS_MOD);
    const float* H1 = (const float*)(p.ws + WS_H1);
    bf16_t* ACT = (bf16_t*)(p.ws + WS_ACT);
    for (int row = row_begin + blockIdx.x * 8 + wave; row < nrows; row += gridDim.x * 8) {
        const float* src = MODE == 0 ? (row < TL ? p.x + (size_t)row * D : p.ctx + (size_t)(row - TL) * D) : (row < TL ? H1 + (size_t)row * D : p.ctx + (size_t)(row - TL) * D);
        const int set = row < 4096 ? 0 : (row < 8192 ? 1 : 2);
        const float* md = MOD + (size_t)set * NMOD;
        f32x4 v[8]; float ss = 0.f;
#pragma unroll
        for (int i = 0; i < 8; ++i) {
            v[i] = *(const f32x4*)(src + (i * 64 + lane) * 4);
            if (MODE == 1 && row >= TL) {
                const float* pp = (const float*)(p.ws + WS_PART) + (size_t)(row - TL) * D + (i * 64 + lane) * 4;
                f32x4 a = *(const f32x4*)pp;
#pragma unroll
                for (int ks = 1; ks < 11; ++ks) a += *(const f32x4*)(pp + (size_t)ks * TCX * D);
                v[i] += a * (*(const f32x4*)(md + 2 * D + (i * 64 + lane) * 4)) * 0.5f;
            }
            ss += v[i][0] * v[i][0] + v[i][1] * v[i][1] + v[i][2] * v[i][2] + v[i][3] * v[i][3]; }
        f32x4 gq[8], scq[8], shq[8];
#pragma unroll
        for (int i = 0; i < 8; ++i) {
            const int col = (i * 64 + lane) * 4;
            gq[i] = *(const f32x4*)(gain + col); scq[i] = *(const f32x4*)(md + scale_idx * D + col); shq[i] = *(const f32x4*)(md + shift_idx * D + col);
        }
        ss = wave_sum(ss);
        const float rs = rsqrtf(ss * (1.f / 2048.f) + 1e-6f);
#pragma unroll
        for (int i = 0; i < 8; ++i) {
            const int col = (i * 64 + lane) * 4;
            const f32x4 o = v[i] * rs * gq[i] * (scq[i] + 1.f) + shq[i];
            u32x2 pk; pk[0] = cvt_pk_bf16(o[0], o[1]); pk[1] = cvt_pk_bf16(o[2], o[3]);
            *(u32x2*)(ACT + (size_t)row * D + col) = pk;
        }
    }
}
__device__ __forceinline__ void phase_ctxnorm(const Params& p, LAS unsigned char* lds) {
    const int tid_ = otid(); const int wave = tid_ >> 6, lane = tid_ & 63, r = wave >> 2, qtr = wave & 3;
    const float* md = (const float*)(p.ws + WS_MOD) + (size_t)2 * NMOD;
    const float* PART = (const float*)(p.ws + WS_PART);
    bf16_t* ACT = (bf16_t*)(p.ws + WS_ACT);
    LAS float* red = (LAS float*)lds;
    for (int rp = blockIdx.x; rp < TCX / 2; rp += gridDim.x) {
        const int rc = rp * 2 + r;
        f32x4 v[2], a[2], m2[2]; f32x4 pr[2][11];
#pragma unroll
        for (int i = 0; i < 2; ++i) {
            const int col = qtr * 512 + (i * 64 + lane) * 4;
            v[i] = *(const f32x4*)(p.ctx + (size_t)rc * D + col);
            m2[i] = *(const f32x4*)(md + 2 * D + col);
#pragma unroll
            for (int ks = 0; ks < 11; ++ks) pr[i][ks] = *(const f32x4*)(PART + ((size_t)ks * TCX + rc) * D + col);
        }
        float ss = 0.f;
#pragma unroll
        for (int i = 0; i < 2; ++i) {
            a[i] = pr[i][0];
#pragma unroll
            for (int ks = 1; ks < 11; ++ks) a[i] += pr[i][ks];
            v[i] += a[i] * m2[i] * 0.5f;
            ss += v[i][0] * v[i][0] + v[i][1] * v[i][1] + v[i][2] * v[i][2] + v[i][3] * v[i][3];
        }
        ss = wave_sum(ss);
        if (lane == 0) red[wave] = ss;
        __syncthreads();
        const float tot = (red[r * 4] + red[r * 4 + 1]) + (red[r * 4 + 2] + red[r * 4 + 3]);
        const float rs = rsqrtf(tot * (1.f / 2048.f) + 1e-6f);
#pragma unroll
        for (int i = 0; i < 2; ++i) {
            const int col = qtr * 512 + (i * 64 + lane) * 4;
            const f32x4 g = *(const f32x4*)(p.norm_mix + col), sc = *(const f32x4*)(md + 4 * D + col), sh = *(const f32x4*)(md + 3 * D + col);
            const f32x4 o = v[i] * rs * g * (sc + 1.f) + sh;
            u32x2 pk; pk[0] = cvt_pk_bf16(o[0], o[1]); pk[1] = cvt_pk_bf16(o[2], o[3]);
            *(u32x2*)(ACT + (size_t)(TL + rc) * D + col) = pk;
        }
        __syncthreads();
    }
}
__device__ __forceinline__ void phase_final(const Params& p) {
    const int tid_ = otid(); const int wave = tid_ >> 6, lane = tid_ & 63;
    const float* H1 = (const float*)(p.ws + WS_H1);
    for (int row = blockIdx.x * 8 + wave; row < TL; row += gridDim.x * 8) {
        const float* src = H1 + (size_t)row * D;
        f32x4 v[8]; float ss = 0.f;
#pragma unroll
        for (int i = 0; i < 8; ++i) { v[i] = *(const f32x4*)(src + (i * 64 + lane) * 4); ss += v[i][0] * v[i][0] + v[i][1] * v[i][1] + v[i][2] * v[i][2] + v[i][3] * v[i][3]; }
        ss = wave_sum(ss);
        const float rs = rsqrtf(ss * (1.f / 2048.f) + 1e-6f);
#pragma unroll
        for (int i = 0; i < 8; ++i) {
            const int col = (i * 64 + lane) * 4;
            const f32x4 g = *(const f32x4*)(p.norm_final + col);
            *(f32x4*)(p.out + (size_t)row * D + col) = v[i] * rs * g;
        }
    }
}

constexpr int L_GKS = 0;
constexpr int L_BC = 8192;
constexpr int L_VT = L_BC + 33024;
constexpr int L_T0 = L_VT + 36864;
constexpr int L_QS = L_T0, L_KS = L_T0 + 17408, L_QE = L_T0 + 2 * 17408, L_ATT = L_T0 + 3 * 17408, L_RED = L_ATT + 9216;
constexpr int L_TOT = L_RED + 2048;
static_assert(L_TOT + 4096 <= LDS_BYTES - 16, "LDS");

__device__ __forceinline__ void gla_stage_common(const Params& p, LAS unsigned char* lds, int row0, int h) {
    const int tid = otid();
    const float* GK = (const float*)(p.ws + WS_GK);
    const bf16_t* PX = (const bf16_t*)(p.ws + WS_PX);
    const int t4 = tid & 15, eg = tid >> 4;
    const f32x4 gkv = *(const f32x4*)(GK + (size_t)(row0 + (tid >> 3)) * 32 + (tid & 7) * 4);
    u32x4 vv[4];
#pragma unroll
    for (int i = 0; i < 4; ++i) vv[i] = *(const u32x4*)(PX + (size_t)(row0 + 4 * t4 + i) * PXW + 512 + h * 256 + eg * 8);
    asm volatile("" :: "v"(gkv), "v"(vv[0]), "v"(vv[1]), "v"(vv[2]), "v"(vv[3]));
    *(LAS f32x4*)(lds + L_GKS + ((tid >> 3) * 32 + (tid & 7) * 4) * 4) = gkv;
#pragma unroll
    for (int k = 0; k < 4; ++k) {
        u32x2 lo, hi;
        lo[0] = (vv[0][k] & 0xffffu) | (vv[1][k] << 16); lo[1] = (vv[2][k] & 0xffffu) | (vv[3][k] << 16);
        hi[0] = (vv[0][k] >> 16) | (vv[1][k] & 0xffff0000u); hi[1] = (vv[2][k] >> 16) | (vv[3][k] & 0xffff0000u);
        *(LAS u32x2*)(lds + L_VT + ((eg * 8 + 2 * k) * 72 + 4 * t4) * 2) = lo;
        *(LAS u32x2*)(lds + L_VT + ((eg * 8 + 2 * k + 1) * 72 + 4 * t4) * 2) = hi;
    }
}
__device__ __forceinline__ void gla_load_w2(const Params& p, int h, int d, int tid, float (&w2r)[16], float& b2) {
    const int j = tid & 127;
#pragma unroll
    for (int r = 0; r < 16; ++r) w2r[r] = p.w_gk2[(size_t)(d * 16 + r) * 512 + h * 128 + j];
    b2 = p.b_gk2[d * 512 + h * 128 + j];
}
__device__ __forceinline__ void gla_logdecay16w(LAS unsigned char* lds, int d, int tid, const float (&w2r)[16], float b2, float (&ld)[16]) {
    const int seg = tid >> 7;
    LAS float* gks = (LAS float*)(lds + L_GKS);
#pragma unroll
    for (int tt = 0; tt < 16; ++tt) {
        const int t = 16 * seg + tt;
        float z = b2;
#pragma unroll
        for (int r4 = 0; r4 < 4; ++r4) {
            const f32x4 gv = *(const LAS f32x4*)(gks + t * 32 + d * 16 + r4 * 4);
            z += gv[0] * w2r[r4 * 4] + gv[1] * w2r[r4 * 4 + 1] + gv[2] * w2r[r4 * 4 + 2] + gv[3] * w2r[r4 * 4 + 3];
        }
        const float e2 = __builtin_amdgcn_exp2f(fabsf(z) * -1.4426950408889634f);
        ld[tt] = fminf(z, 0.f) * (1.f / 16.f) - 0.04332169878499658f * __builtin_amdgcn_logf(1.f + e2);
    }
}
__device__ __forceinline__ void gla_logdecay16(const Params& p, LAS unsigned char* lds, int h, int d, int tid, float (&ld)[16]) {
    float w2r[16], b2; gla_load_w2(p, h, d, tid, w2r, b2); gla_logdecay16w(lds, d, tid, w2r, b2, ld);
}
__device__ __forceinline__ void gla_cumdecay(const Params& p, LAS unsigned char* lds, int h, int d) {
    const int tid = otid(), j = tid & 127, seg = tid >> 7;
    LAS float* bc = (LAS float*)(lds + L_BC);
    LAS float* tot = (LAS float*)(lds + L_TOT);
    float ld[16];
    gla_logdecay16(p, lds, h, d, tid, ld);
    float run = 0.f;
    if (d == 0) {
#pragma unroll
        for (int tt = 0; tt < 16; ++tt) { run += ld[tt]; ld[tt] = run; }
    } else {
#pragma unroll
        for (int tt = 15; tt >= 0; --tt) { run += ld[tt]; ld[tt] = run; }
    }
    tot[seg * 128 + j] = run;
    __syncthreads();
    float off = 0.f;
#pragma unroll
    for (int sg = 0; sg < 4; ++sg) { const float tv = tot[sg * 128 + j]; const bool use = d == 0 ? (sg < seg) : (sg > seg); off += use ? tv : 0.f; }
#pragma unroll
    for (int tt = 0; tt < 16; ++tt) bc[(16 * seg + tt) * 129 + j] = ld[tt] + off;
    __syncthreads();
}

__device__ __forceinline__ void gla_a_item(const Params& p, LAS unsigned char* lds, int item, int dsel) {
    const int tid = otid(), wid = tid >> 6, lane = tid & 63, fr = lane & 15, fq = lane >> 4;
    const int bh = item / NSLOT, slot = item % NSLOT, b = bh >> 2, h = bh & 3;
    const int row0 = slot < 4 ? TL + b * 256 + slot * 64 : b * 4096 + (slot - 4) * 64;
    const bf16_t* PX = (const bf16_t*)(p.ws + WS_PX);
    bf16_t* KVT = (bf16_t*)(p.ws + WS_HID);
    float* DEC = (float*)(p.ws + WS_DEC);
    LAS float* tot = (LAS float*)(lds + L_TOT);
    const int j = tid & 127, seg = tid >> 7;
    gla_stage_common(p, lds, row0, h);
    float kf[16];
#pragma unroll
    for (int tt = 0; tt < 16; ++tt) kf[tt] = bf_lo((unsigned)PX[(size_t)(row0 + 16 * seg + tt) * PXW + h * 128 + j]);
    float w2f[16], w2b[16], b2f, b2b;
    gla_load_w2(p, h, 0, tid, w2f, b2f); gla_load_w2(p, h, 1, tid, w2b, b2b);
    __syncthreads();
    const bool do_f = dsel != 2, do_b = dsel != 1;
    float lf[16], lb[16];
    if (do_f) gla_logdecay16w(lds, 0, tid, w2f, b2f, lf); else {
#pragma unroll
        for (int q = 0; q < 16; ++q) lf[q] = 0.f; }
    if (do_b) gla_logdecay16w(lds, 1, tid, w2b, b2b, lb); else {
#pragma unroll
        for (int q = 0; q < 16; ++q) lb[q] = 0.f; }
    float tf = 0.f, tb = 0.f;
#pragma unroll
    for (int tt = 15; tt >= 0; --tt) { const float v = lf[tt]; lf[tt] = tf; tf += v; }
#pragma unroll
    for (int tt = 0; tt < 16; ++tt) { const float v = lb[tt]; lb[tt] = tb; tb += v; }
    tot[seg * 128 + j] = tf; tot[512 + seg * 128 + j] = tb;
    __syncthreads();
    float of = 0.f, ob = 0.f, sf = 0.f, sb = 0.f;
#pragma unroll
    for (int sg = 0; sg < 4; ++sg) { const float a = tot[sg * 128 + j], c = tot[512 + sg * 128 + j]; sf += a; sb += c; of += sg > seg ? a : 0.f; ob += sg < seg ? c : 0.f; }
    if (do_f) {
        u32x4 w0, w1;
#pragma unroll
        for (int q = 0; q < 4; ++q) {
            w0[q] = cvt_pk_bf16(kf[2 * q] * __expf(lf[2 * q] + of), kf[2 * q + 1] * __expf(lf[2 * q + 1] + of));
            w1[q] = cvt_pk_bf16(kf[8 + 2 * q] * __expf(lf[8 + 2 * q] + of), kf[8 + 2 * q + 1] * __expf(lf[8 + 2 * q + 1] + of));
        }
        *(LAS u32x4*)(lds + L_T0 + (j * 72 + 16 * seg) * 2) = w0; *(LAS u32x4*)(lds + L_T0 + (j * 72 + 16 * seg + 8) * 2) = w1;
    }
    if (do_b) {
        u32x4 w2, w3;
#pragma unroll
        for (int q = 0; q < 4; ++q) {
            w2[q] = cvt_pk_bf16(kf[2 * q] * __expf(lb[2 * q] + ob), kf[2 * q + 1] * __expf(lb[2 * q + 1] + ob));
            w3[q] = cvt_pk_bf16(kf[8 + 2 * q] * __expf(lb[8 + 2 * q] + ob), kf[8 + 2 * q + 1] * __expf(lb[8 + 2 * q + 1] + ob));
        }
        *(LAS u32x4*)(lds + L_T0 + 18432 + (j * 72 + 16 * seg) * 2) = w2; *(LAS u32x4*)(lds + L_T0 + 18432 + (j * 72 + 16 * seg + 8) * 2) = w3;
    }
    if (slot >= 4) {
        float bef = 0.f, aft = 0.f;
#pragma unroll
        for (int sg = 0; sg < 4; ++sg) { bef += sg < seg ? tot[sg * 128 + j] : 0.f; aft += sg > seg ? tot[512 + sg * 128 + j] : 0.f; }
        float* bcf = (float*)(p.ws + WS_BC) + (((size_t)(0 * 8 + bh) * 64 + (slot - 4)) * 64 + 16 * seg) * 128 + j;
        float* bcb = (float*)(p.ws + WS_BC) + (((size_t)(1 * 8 + bh) * 64 + (slot - 4)) * 64 + 16 * seg) * 128 + j;
#pragma unroll
        for (int tt = 0; tt < 16; ++tt) { if (do_f) bcf[tt * 128] = (tf - lf[tt]) + bef; if (do_b) bcb[tt * 128] = (tb - lb[tt]) + aft; }
        bf16_t* vtg = (bf16_t*)(p.ws + WS_VT) + ((size_t)bh * 64 + (slot - 4)) * 256 * 64;
        if (do_f)
#pragma unroll
        for (int it = 0; it < 4; ++it) {
            const int id = tid + 512 * it, e = id >> 3, cq = id & 7;
            *(u32x4*)(vtg + e * 64 + cq * 8) = *(const LAS u32x4*)(lds + L_VT + e * 144 + cq * 16);
        }
    }
    if (seg == 0 && do_f) DEC[((size_t)(0 * 8 + bh) * NSLOT + slot) * 128 + j] = __expf(sf);
    if (seg == 1 && do_b) DEC[((size_t)(1 * 8 + bh) * NSLOT + slot) * 128 + j] = __expf(sb);
    __syncthreads();
    for (int d = 0; d < 2; ++d) {
        if (d == 0 ? !do_f : !do_b) continue;
        f32x4 acc[2][8];
#pragma unroll
        for (int et = 0; et < 2; ++et)
#pragma unroll
            for (int jt = 0; jt < 8; ++jt) acc[et][jt] = (f32x4){0.f, 0.f, 0.f, 0.f};
#pragma unroll
        for (int ks = 0; ks < 2; ++ks) {
            bf16x8 bv[2];
#pragma unroll
            for (int et = 0; et < 2; ++et) bv[et] = *(const LAS bf16x8*)(lds + L_VT + (32 * wid + 16 * et + fr) * 144 + (ks * 32 + fq * 8) * 2);
#pragma unroll
            for (int jt = 0; jt < 8; ++jt) {
                const bf16x8 av = *(const LAS bf16x8*)(lds + L_T0 + d * 18432 + (16 * jt + fr) * 144 + (ks * 32 + fq * 8) * 2);
#pragma unroll
                for (int et = 0; et < 2; ++et) acc[et][jt] = __builtin_amdgcn_mfma_f32_16x16x32_bf16(av, bv[et], acc[et][jt], 0, 0, 0);
            }
        }
        bf16_t* kvb = KVT + ((size_t)(d * 8 + bh) * NSLOT + slot) * 32768;
#pragma unroll
        for (int et = 0; et < 2; ++et)
#pragma unroll
            for (int jt = 0; jt < 8; ++jt) {
                u32x2 pk; pk[0] = cvt_pk_bf16(acc[et][jt][0], acc[et][jt][1]); pk[1] = cvt_pk_bf16(acc[et][jt][2], acc[et][jt][3]);
                *(u32x2*)(kvb + (32 * wid + 16 * et + fr) * 128 + 16 * jt + 4 * fq) = pk;
            }
    }
}

template <int NT>
__device__ __forceinline__ void conv_window(const bf16_t* ubase, size_t stride_el, int p0, const LAS float* cwl, float (*y)[8]) {
    constexpr int PFD = 8;
    float wv[NT][8]; u32x4 pf[PFD];
    const bf16_t* ptr = ubase + (ptrdiff_t)p0 * (ptrdiff_t)stride_el;
#pragma unroll
    for (int q = 0; q < NT; ++q) {
        u32x4 v = *(const u32x4*)ptr; ptr += stride_el;
        const int pos = p0 + q; if (pos < 0 || pos > 63) v = (u32x4){0u, 0u, 0u, 0u};
#pragma unroll
        for (int i = 0; i < 4; ++i) { wv[q][2 * i] = bf_lo(v[i]); wv[q][2 * i + 1] = bf_hi(v[i]); }
    }
#pragma unroll
    for (int q = 0; q < PFD; ++q) { pf[q] = *(const u32x4*)ptr; ptr += stride_el; }
#pragma unroll 1
    for (int j0 = 0; j0 < 32; j0 += 8) {
#pragma unroll
        for (int jj = 0; jj < 8; ++jj) {
            const int j = j0 + jj;
            const f32x4 c0 = *(const LAS f32x4*)(cwl + j * 1024), c1 = *(const LAS f32x4*)(cwl + j * 1024 + 4);
#pragma unroll
            for (int tk = 0; tk < NT; ++tk) {
                const float (&w)[8] = wv[(tk + jj) % NT];
                y[tk][0] += w[0] * c0[0]; y[tk][1] += w[1] * c0[1]; y[tk][2] += w[2] * c0[2]; y[tk][3] += w[3] * c0[3];
                y[tk][4] += w[4] * c1[0]; y[tk][5] += w[5] * c1[1]; y[tk][6] += w[6] * c1[2]; y[tk][7] += w[7] * c1[3];
            }
            {
                u32x4 v = pf[jj];
                const int pos = p0 + NT + j; if (pos < 0 || pos > 63) v = (u32x4){0u, 0u, 0u, 0u};
                float (&w)[8] = wv[jj % NT];
#pragma unroll
                for (int i = 0; i < 4; ++i) { w[2 * i] = bf_lo(v[i]); w[2 * i + 1] = bf_hi(v[i]); }
            }
            pf[jj] = *(const u32x4*)ptr; ptr += stride_el;
        }
    }
}
__device__ __forceinline__ void conv_item(const Params& p, LAS unsigned char* lds, int item) {
    const int tid = otid(), wid = tid >> 6;
    const int b = item >> 7, r0 = ((item >> 3) & 15) * 4, w0 = (item & 7) * 8;
    const bf16_t* U = (const bf16_t*)(p.ws + WS_U);
    bf16_t* OCAT = (bf16_t*)(p.ws + WS_ACT);
    LAS float* red = (LAS float*)lds;
    const int cg = tid & 127, ch = cg * 8, tg = tid >> 7;
    const bool rowconv = cg < 64;
    float bias[8], lg[8], lb[8];
    { const f32x4 b0 = *(const f32x4*)(p.conv_b + ch), b1 = *(const f32x4*)(p.conv_b + ch + 4);
      const f32x4 g0 = *(const f32x4*)(p.conv_ln_g + ch), g1 = *(const f32x4*)(p.conv_ln_g + ch + 4);
      const f32x4 l0 = *(const f32x4*)(p.conv_ln_b + ch), l1 = *(const f32x4*)(p.conv_ln_b + ch + 4);
#pragma unroll
      for (int i = 0; i < 4; ++i) { bias[i] = b0[i]; bias[4 + i] = b1[i]; lg[i] = g0[i]; lg[4 + i] = g1[i]; lb[i] = l0[i]; lb[4 + i] = l1[i]; } }
    LAS float* cwl = (LAS float*)(lds + 512);
    {
        f32x4 cwv[16];
#pragma unroll
        for (int q = 0; q < 16; ++q) { const int i = tid + 512 * q; const int ic = i < 31 * 256 ? i : 0; cwv[q] = *(const f32x4*)(p.conv_w + ic * 4); if (i >= 31 * 256) cwv[q] = (f32x4){0.f, 0.f, 0.f, 0.f}; }
#pragma unroll
        for (int q = 0; q < 16; ++q) *(LAS f32x4*)(cwl + (tid + 512 * q) * 4) = cwv[q];
    }
    __syncthreads();
    float y[8][8];
#pragma unroll
    for (int tk = 0; tk < 8; ++tk)
#pragma unroll
        for (int i = 0; i < 8; ++i) y[tk][i] = bias[i];
    int ltok[8];
    if (rowconv) {
        conv_window<8>(U + (size_t)(b * 4096 + (r0 + tg) * 64) * 1024 + ch, 1024, w0 - 15, cwl + ch, &y[0]);
#pragma unroll
        for (int tk = 0; tk < 8; ++tk) ltok[tk] = tg * 8 + tk;
    } else {
        conv_window<4>(U + (size_t)(b * 4096 + w0 + 2 * tg) * 1024 + ch, 64 * 1024, r0 - 15, cwl + ch, &y[0]);
        conv_window<4>(U + (size_t)(b * 4096 + w0 + 2 * tg + 1) * 1024 + ch, 64 * 1024, r0 - 15, cwl + ch, &y[4]);
#pragma unroll
        for (int tk = 0; tk < 8; ++tk) ltok[tk] = (tk & 3) * 8 + 2 * tg + (tk >> 2);
    }
    const int half = rowconv ? 0 : 1;
#pragma unroll
    for (int tk = 0; tk < 8; ++tk) {
        float s1 = 0.f, s2 = 0.f;
#pragma unroll
        for (int i = 0; i < 8; ++i) { s1 += y[tk][i]; s2 += y[tk][i] * y[tk][i]; }
        s1 = wave_sum(s1); s2 = wave_sum(s2);
        if ((tid & 63) == 0) { red[(ltok[tk] * 2 + half) * 2] = s1; red[(ltok[tk] * 2 + half) * 2 + 1] = s2; }
    }
    __syncthreads();
#pragma unroll
    for (int tk = 0; tk < 8; ++tk) {
        const int lt = ltok[tk];
        const float mean = (red[lt * 4] + red[lt * 4 + 2]) * (1.f / 1024.f);
        const float var = (red[lt * 4 + 1] + red[lt * 4 + 3]) * (1.f / 1024.f) - mean * mean;
        const float rstd = rsqrtf(fmaxf(var, 0.f) + 1e-5f);
        float o[8];
#pragma unroll
        for (int i = 0; i < 8; ++i) { const float yn = (y[tk][i] - mean) * rstd * lg[i] + lb[i]; o[i] = silu_f(yn); }
        u32x4 pk; pk[0] = cvt_pk_bf16(o[0], o[1]); pk[1] = cvt_pk_bf16(o[2], o[3]); pk[2] = cvt_pk_bf16(o[4], o[5]); pk[3] = cvt_pk_bf16(o[6], o[7]);
        const int tok = b * 4096 + (r0 + (lt >> 3)) * 64 + w0 + (lt & 7);
        if (DBG_ZERO_CONV) { pk[0] = 0; pk[1] = 0; pk[2] = 0; pk[3] = 0; }
        *(u32x4*)(OCAT + (size_t)tok * D + 1024 + ch) = pk;
    }
    (void)wid;
}

__device__ __forceinline__ void phase_gla_a_conv(const Params& p, LAS unsigned char* lds) {
    const int nItems = 256 + 512 + 64;
    for (int it = blockIdx.x; it < nItems; it += gridDim.x) {
        if (it < 256) conv_item(p, lds, it);
        else if (it < 768) gla_a_item(p, lds, it - 256, 0);
        else { const int hh = it - 768; gla_a_item(p, lds, 512 + (hh >> 1), 1 + (hh & 1)); }
        __syncthreads();
    }
}

template <int DIR>
__device__ __forceinline__ void scan_one(bf16_t* base, const float* db) {
    f32x4 S = {0.f, 0.f, 0.f, 0.f};
    {
        u32x2 kv[4]; f32x4 dc[4];
#pragma unroll
        for (int q = 0; q < 4; ++q) { const int slot = DIR == 0 ? q : 3 - q; kv[q] = *(const u32x2*)(base + (size_t)slot * 32768); dc[q] = *(const f32x4*)(db + slot * 128); }
#pragma unroll
        for (int q = 0; q < 4; ++q) { S[0] = dc[q][0] * S[0] + bf_lo(kv[q][0]); S[1] = dc[q][1] * S[1] + bf_hi(kv[q][0]); S[2] = dc[q][2] * S[2] + bf_lo(kv[q][1]); S[3] = dc[q][3] * S[3] + bf_hi(kv[q][1]); }
    }
#pragma unroll 1
    for (int b0 = 0; b0 < 64; b0 += 16) {
        u32x2 kv[16]; f32x4 dc[16];
#pragma unroll
        for (int q = 0; q < 16; ++q) { const int slot = DIR == 0 ? 4 + b0 + q : 67 - b0 - q; kv[q] = *(const u32x2*)(base + (size_t)slot * 32768); dc[q] = *(const f32x4*)(db + slot * 128); }
#pragma unroll
        for (int q = 0; q < 16; ++q) {
            const int slot = DIR == 0 ? 4 + b0 + q : 67 - b0 - q;
            u32x2 pk; pk[0] = cvt_pk_bf16(S[0], S[1]); pk[1] = cvt_pk_bf16(S[2], S[3]);
            *(u32x2*)(base + (size_t)slot * 32768) = pk;
            S[0] = dc[q][0] * S[0] + bf_lo(kv[q][0]); S[1] = dc[q][1] * S[1] + bf_hi(kv[q][0]); S[2] = dc[q][2] * S[2] + bf_lo(kv[q][1]); S[3] = dc[q][3] * S[3] + bf_hi(kv[q][1]);
        }
    }
}
__device__ __forceinline__ void phase_scan(const Params& p) {
    bf16_t* KVT = (bf16_t*)(p.ws + WS_HID);
    const float* DEC = (const float*)(p.ws + WS_DEC);
    for (int gid = blockIdx.x * 512 + otid(); gid < 2 * 8 * 256 * 32; gid += gridDim.x * 512) {
        const int d = gid >> 16, bh = (gid >> 13) & 7, e = (gid >> 5) & 255, jg = gid & 31;
        bf16_t* base = KVT + (size_t)(d * 8 + bh) * NSLOT * 32768 + e * 128 + jg * 4;
        const float* db = DEC + (size_t)(d * 8 + bh) * NSLOT * 128 + jg * 4;
        if (d == 0) scan_one<0>(base, db); else scan_one<1>(base, db);
    }
}

__device__ __forceinline__ void gla_c_item(const Params& p, LAS unsigned char* lds, int item) {
    const int tid = otid(), wid = tid >> 6, lane = tid & 63, fr = lane & 15, fq = lane >> 4;
    const int bh = item >> 6, n = item & 63, b = bh >> 2, h = bh & 3, slot = 4 + n;
    const int row0 = b * 4096 + n * 64;
    const bf16_t* PX = (const bf16_t*)(p.ws + WS_PX);
    const bf16_t* KVT = (const bf16_t*)(p.ws + WS_HID);
    bf16_t* OCAT = (bf16_t*)(p.ws + WS_ACT);
    LAS float* bc = (LAS float*)(lds + L_BC);
    const float* bcg = (const float*)(p.ws + WS_BC) + ((size_t)bh * 64 + n) * 64 * 128;
    f32x4 bcv[2][4];
#pragma unroll
    for (int d = 0; d < 2; ++d)
#pragma unroll
        for (int it = 0; it < 4; ++it) bcv[d][it] = *(const f32x4*)(bcg + (size_t)d * 8 * 64 * 64 * 128 + (size_t)(tid + 512 * it) * 4);
    const bf16_t* vtg = (const bf16_t*)(p.ws + WS_VT) + ((size_t)bh * 64 + n) * 256 * 64;
    bf16x8 vfr[2][2];
#pragma unroll
    for (int ks = 0; ks < 2; ++ks)
#pragma unroll
        for (int et = 0; et < 2; ++et) vfr[ks][et] = *(const bf16x8*)(vtg + (32 * wid + 16 * et + fr) * 64 + ks * 32 + fq * 8);
    f32x4 o[2][4];
#pragma unroll
    for (int et = 0; et < 2; ++et)
#pragma unroll
        for (int tt = 0; tt < 4; ++tt) o[et][tt] = (f32x4){0.f, 0.f, 0.f, 0.f};
    for (int d = 0; d < 2; ++d) {
#pragma unroll
        for (int it = 0; it < 4; ++it) {
            const int id = tid + 512 * it, t = id >> 5, j4 = (id & 31) * 4;
            const f32x4 v = d == 0 ? bcv[0][it] : bcv[1][it];
            bc[t * 129 + j4] = v[0]; bc[t * 129 + j4 + 1] = v[1]; bc[t * 129 + j4 + 2] = v[2]; bc[t * 129 + j4 + 3] = v[3];
        }
        __syncthreads();
        const int tm = d == 0 ? 31 : 32;
        { const int t = tid & 63;
#pragma unroll
          for (int it = 0; it < 2; ++it) {
              const int jg = (tid >> 6) + 8 * it;
              const u32x4 qv = *(const u32x4*)(PX + (size_t)(row0 + t) * PXW + 1536 + h * 128 + jg * 8);
              const u32x4 kv = *(const u32x4*)(PX + (size_t)(row0 + t) * PXW + h * 128 + jg * 8);
              float qs[8], ks[8], qe[8];
#pragma unroll
              for (int i = 0; i < 8; ++i) {
                  const int j = jg * 8 + i;
                  const float qf = ((i & 1) ? bf_hi(qv[i >> 1]) : bf_lo(qv[i >> 1])) * 0.08838834764831845f;
                  const float kf = (i & 1) ? bf_hi(kv[i >> 1]) : bf_lo(kv[i >> 1]);
                  const float bb = bc[t * 129 + j], bm = bc[tm * 129 + j];
                  qs[i] = qf * __expf(bb - bm); ks[i] = kf * __expf(bm - bb); qe[i] = qf * __expf(bb);
              }
              u32x4 a, c, e;
#pragma unroll
              for (int i = 0; i < 4; ++i) { a[i] = cvt_pk_bf16(qs[2 * i], qs[2 * i + 1]); c[i] = cvt_pk_bf16(ks[2 * i], ks[2 * i + 1]); e[i] = cvt_pk_bf16(qe[2 * i], qe[2 * i + 1]); }
              *(LAS u32x4*)(lds + L_QS + t * 272 + jg * 16) = a;
              *(LAS u32x4*)(lds + L_KS + t * 272 + jg * 16) = c;
              *(LAS u32x4*)(lds + L_QE + t * 272 + jg * 16) = e;
          } }
        __syncthreads();
        { const int tt = wid & 3;
#pragma unroll
          for (int sh = 0; sh < 2; ++sh) {
              const int st = (wid >> 2) * 2 + sh;
              f32x4 a = {0.f, 0.f, 0.f, 0.f};
#pragma unroll
              for (int ks = 0; ks < 4; ++ks) {
                  const bf16x8 av = *(const LAS bf16x8*)(lds + L_KS + (16 * st + fr) * 272 + (ks * 32 + fq * 8) * 2);
                  const bf16x8 bv = *(const LAS bf16x8*)(lds + L_QS + (16 * tt + fr) * 272 + (ks * 32 + fq * 8) * 2);
                  a = __builtin_amdgcn_mfma_f32_16x16x32_bf16(av, bv, a, 0, 0, 0);
              }
              const int t = 16 * tt + fr, s0 = 16 * st + 4 * fq;
              float m[4];
#pragma unroll
              for (int i = 0; i < 4; ++i) { const int s = s0 + i; const bool keep = d == 0 ? (s <= t) : (s >= t); m[i] = keep ? a[i] : 0.f; }
              u32x2 pk; pk[0] = cvt_pk_bf16(m[0], m[1]); pk[1] = cvt_pk_bf16(m[2], m[3]);
              *(LAS u32x2*)(lds + L_ATT + t * 144 + s0 * 2) = pk;
          } }
        __syncthreads();
#pragma unroll
        for (int ks = 0; ks < 2; ++ks) {
#pragma unroll
            for (int tt = 0; tt < 4; ++tt) {
                const bf16x8 bv = *(const LAS bf16x8*)(lds + L_ATT + (16 * tt + fr) * 144 + (ks * 32 + fq * 8) * 2);
#pragma unroll
                for (int et = 0; et < 2; ++et) o[et][tt] = __builtin_amdgcn_mfma_f32_16x16x32_bf16(vfr[ks][et], bv, o[et][tt], 0, 0, 0);
            }
        }
        const bf16_t* sb = KVT + ((size_t)(d * 8 + bh) * NSLOT + slot) * 32768;
#pragma unroll
        for (int ks = 0; ks < 4; ++ks) {
            bf16x8 av[2];
#pragma unroll
            for (int et = 0; et < 2; ++et) av[et] = *(const bf16x8*)(sb + (32 * wid + 16 * et + fr) * 128 + ks * 32 + fq * 8);
#pragma unroll
            for (int tt = 0; tt < 4; ++tt) {
                const bf16x8 bv = *(const LAS bf16x8*)(lds + L_QE + (16 * tt + fr) * 272 + (ks * 32 + fq * 8) * 2);
#pragma unroll
                for (int et = 0; et < 2; ++et) o[et][tt] = __builtin_amdgcn_mfma_f32_16x16x32_bf16(av[et], bv, o[et][tt], 0, 0, 0);
            }
        }
        __syncthreads();
    }
    LAS float* red = (LAS float*)(lds + L_RED);
#pragma unroll
    for (int tt = 0; tt < 4; ++tt) {
        float s = 0.f;
#pragma unroll
        for (int et = 0; et < 2; ++et)
#pragma unroll
            for (int i = 0; i < 4; ++i) s += o[et][tt][i] * o[et][tt][i];
        s += __shfl_xor(s, 16, 64); s += __shfl_xor(s, 32, 64);
        if (fq == 0) red[wid * 64 + 16 * tt + fr] = s;
    }
    __syncthreads();
#pragma unroll
    for (int tt = 0; tt < 4; ++tt) {
        const int t = 16 * tt + fr;
        float tot = 0.f;
#pragma unroll
        for (int w = 0; w < 8; ++w) tot += red[w * 64 + t];
        const float rs = rsqrtf(tot * (1.f / 256.f) + 1e-5f);
#pragma unroll
        for (int et = 0; et < 2; ++et) {
            const int e = 32 * wid + 16 * et + 4 * fq;
            const f32x4 gn = *(const f32x4*)(p.gla_norm + e);
            const u32x2 gv = *(const u32x2*)(PX + (size_t)(row0 + t) * PXW + 2048 + h * 256 + e);
            const float g0 = bf_lo(gv[0]), g1 = bf_hi(gv[0]), g2 = bf_lo(gv[1]), g3 = bf_hi(gv[1]);
            const float v0 = o[et][tt][0] * rs * gn[0] * silu_f(g0), v1 = o[et][tt][1] * rs * gn[1] * silu_f(g1);
            const float v2 = o[et][tt][2] * rs * gn[2] * silu_f(g2), v3 = o[et][tt][3] * rs * gn[3] * silu_f(g3);
            u32x2 pk; pk[0] = cvt_pk_bf16(v0, v1); pk[1] = cvt_pk_bf16(v2, v3);
            if (DBG_ZERO_GLA) { pk[0] = 0; pk[1] = 0; }
            *(u32x2*)(OCAT + (size_t)(row0 + t) * D + h * 256 + e) = pk;
        }
    }
}
__device__ __forceinline__ void phase_gla_c(const Params& p, LAS unsigned char* lds) {
    for (int it = blockIdx.x; it < 512; it += gridDim.x) { gla_c_item(p, lds, it); __syncthreads(); }
}

__device__ __forceinline__ void run_gemm_gate(const Params& p, LAS unsigned char* lds, bool first) {
    unsigned char* ws = p.ws;
    Gemm g; g.A = (const bf16_t*)(ws + WS_ACT); g.Bt = (const bf16_t*)(ws + (first ? WS_WT1 : WS_WT5)); g.M = first ? MT : TL; g.N = NFF; g.K = D;
    Order S; S.init(g.M / BM, NFF / BM, gridDim.x, blockIdx.x, 0, D / BK);
    EpiGate E; E.H = (bf16_t*)(ws + WS_HID);
    gemm_phase(lds, g, S, E);
}
template <int WHICH>
__device__ __forceinline__ void run_gemm_resid(const Params& p, LAS unsigned char* lds) {
    constexpr int which = WHICH;
    unsigned char* ws = p.ws;
    float* H1 = (float*)(ws + WS_H1);
    Gemm g; EpiResid<(WHICH == 2 ? 2 : 1)> E; E.mod = (const float*)(ws + WS_MOD); E.out = H1; E.part = (float*)(ws + WS_PART);
    E.st.xbuf = (unsigned*)(ws + WS_XB); E.st.cnt = (unsigned*)(ws + WS_CNT) + which * 32 * 64; E.gain = which == 2 ? p.norm_final : (which == 1 ? p.norm_ffn2 : p.norm_mix); E.sh_idx = which == 0 ? 3 : 6; E.sc_idx = which == 0 ? 4 : 7; E.act = (bf16_t*)(ws + WS_ACT); E.fout = p.out;
    if (which == 0) { g.A = (const bf16_t*)(ws + WS_HID); g.Bt = (const bf16_t*)(ws + WS_WT2); g.M = TL; g.K = DFF; E.resid_lat = p.x; E.resid_ctx = p.ctx; E.gidx = 2; E.gs = 0.5f; }
    else if (which == 1) { g.A = (const bf16_t*)(ws + WS_ACT); g.Bt = (const bf16_t*)(ws + WS_WT4); g.M = TL; g.K = D; E.resid_lat = H1; E.resid_ctx = H1; E.gidx = 5; E.gs = 1.0f; }
    else { g.A = (const bf16_t*)(ws + WS_HID); g.Bt = (const bf16_t*)(ws + WS_WT6); g.M = TL; g.K = DFF; E.resid_lat = H1; E.resid_ctx = H1; E.gidx = 8; E.gs = 0.5f; }
    g.N = D;
    Order S; S.init(g.M / BM, D / BM, gridDim.x, blockIdx.x, which == 0 ? 2 : 0, g.K / BK);
    gemm_phase(lds, g, S, E);
}
__device__ __forceinline__ void run_gemm_in(const Params& p, LAS unsigned char* lds) {
    unsigned char* ws = p.ws;
    Gemm g; g.A = (const bf16_t*)(ws + WS_ACT); g.Bt = (const bf16_t*)(ws + WS_WT3); g.M = TL; g.N = N3; g.K = D;
    Order S; S.init(TL / BM, N3 / BM, gridDim.x, blockIdx.x, 1, D / BK);
    EpiIn E; E.PX = (bf16_t*)(ws + WS_PX); E.U = (bf16_t*)(ws + WS_U); E.GK = (float*)(ws + WS_GK);
    gemm_phase(lds, g, S, E);
}


#define XB_TMO      128
#define XB_XCNT(j)  (256  + 64 * (j))
#define XB_XSUB(j)  (1280 + 64 * (j))
#define XB_XGEN(j)  (2304 + 64 * (j))
#define XB_TOP      3328
#define XB_TOPGEN   3392
#define XCD_BAR_WORDS 3456
#define XB_SPIN_CAP (1u << 18)
__device__ __forceinline__ unsigned xb_ld(unsigned* p)              { return __hip_atomic_load(p, __ATOMIC_RELAXED, __HIP_MEMORY_SCOPE_AGENT); }
__device__ __forceinline__ unsigned xb_add(unsigned* p, unsigned v) { return __hip_atomic_fetch_add(p, v, __ATOMIC_RELAXED, __HIP_MEMORY_SCOPE_AGENT); }
__device__ __forceinline__ unsigned xb_xcc_id() { return (unsigned)__builtin_amdgcn_s_getreg((3 << 11) | 20) & 0xFu; }
#define XB_SPIN(cond, bar) do { unsigned _sp = 0; while (cond) { __builtin_amdgcn_s_sleep(1); \
    if ((++_sp & 255u) == 0u) { if (xb_ld(&(bar)[XB_TMO])) break; if (_sp > XB_SPIN_CAP) { atomicAdd(&(bar)[XB_TMO], 1u); break; } } } } while (0)
struct XcdBarrier { unsigned* bar; unsigned x; volatile LAS unsigned* st; };
__device__ __forceinline__ XcdBarrier xcd_barrier_post(unsigned* bar, volatile LAS unsigned* st) {
    XcdBarrier b; b.bar = bar; b.x = xb_xcc_id(); b.st = st;
    if (threadIdx.x == 0) (void)xb_add(&bar[XB_XCNT(b.x)], 1u);
    return b;
}
__device__ __forceinline__ void xcd_barrier_complete(unsigned* bar, unsigned x, unsigned& nloc, unsigned& nx) {
    const unsigned G = gridDim.x * gridDim.y * gridDim.z;
    unsigned sum, cnt, mine, sp = 0u;
    for (;;) {
        sum = 0u; cnt = 0u; mine = 0u;
#pragma unroll
        for (unsigned j = 0; j < 16; ++j) { const unsigned c = xb_ld(&bar[XB_XCNT(j)]); sum += c; cnt += (c > 0u) ? 1u : 0u; mine = (j == x) ? c : mine; }
        if (sum == G) break;
        __builtin_amdgcn_s_sleep(1);
        if ((++sp & 255u) == 0u) { if (xb_ld(&bar[XB_TMO])) break; if (sp > XB_SPIN_CAP) { atomicAdd(&bar[XB_TMO], 1u); break; } }
    }
    nloc = mine > 0u ? mine : 1u; nx = cnt > 0u ? cnt : 1u;
}
__device__ __forceinline__ void xcd_barrier(const XcdBarrier& b) {
    asm volatile("s_waitcnt vmcnt(0)" ::: "memory");
    __syncthreads();
    if (threadIdx.x == 0) {
        unsigned* bar = b.bar;
        __builtin_amdgcn_s_waitcnt(0);
        unsigned nloc = b.st[0], nx = b.st[1];
        if (nloc == 0u) { xcd_barrier_complete(bar, b.x, nloc, nx); b.st[0] = nloc; b.st[1] = nx; }
        const unsigned old = xb_add(&bar[XB_XSUB(b.x)], 1u);
        const unsigned gen = old / nloc;
        if (old + 1u == (gen + 1u) * nloc) {
            __builtin_amdgcn_fence(__ATOMIC_RELEASE, "agent");
            asm volatile("s_waitcnt vmcnt(0)" ::: "memory");
            const unsigned og = xb_add(&bar[XB_TOP], 1u);
            const unsigned tg = og / nx;
            if (og + 1u == (tg + 1u) * nx) xb_add(&bar[XB_TOPGEN], 1u);
            else XB_SPIN(xb_ld(&bar[XB_TOPGEN]) == tg, bar);
            __builtin_amdgcn_fence(__ATOMIC_ACQUIRE, "agent");
            xb_add(&bar[XB_XGEN(b.x)], 1u);
            asm volatile("s_waitcnt vmcnt(0)" ::: "memory");
        } else {
            XB_SPIN(xb_ld(&bar[XB_XGEN(b.x)]) == gen, bar);
            __builtin_amdgcn_fence(__ATOMIC_ACQUIRE, "agent");
            asm volatile("s_waitcnt vmcnt(0)" ::: "memory");
        }
    }
    __syncthreads();
}

__device__ __forceinline__ void grid_barrier(cg::grid_group& grid) {
    asm volatile("s_waitcnt vmcnt(0)" ::: "memory");
    __syncthreads();
    grid.sync();
    __builtin_amdgcn_fence(__ATOMIC_ACQUIRE, "agent");
    asm volatile("s_waitcnt vmcnt(0)" ::: "memory");
    __syncthreads();
}
#ifndef DBG_AFTER
#define DBG_AFTER -1
#endif
#ifndef DBG_OFF
#define DBG_OFF WS_HID
#endif
#ifndef DBG_F32
#define DBG_F32 0
#endif
__device__ __forceinline__ void dbg_dump(const Params& p) {
    const size_t n = (size_t)TL * D;
    for (size_t i = (size_t)blockIdx.x * 512 + threadIdx.x; i < n; i += (size_t)gridDim.x * 512) {
        float v;
        if (DBG_F32) v = ((const float*)(p.ws + DBG_OFF))[i]; else v = bf_lo(((const bf16_t*)(p.ws + DBG_OFF))[i]);
        if (!(fabsf(v) < 1e30f)) v = 777.f;
        p.out[i] = v;
    }
}
#define PHASE(n, body) do { if (ph_lo <= (n) && (n) < ph_hi) { if constexpr (((REP_MASK) >> (n)) & 1) { body; xcd_barrier(xb); } if constexpr (PH_ON(n)) { body; } if ((n) + 1 < ph_hi && (n) != 12) { if ((n) == 0) grid_barrier(grid); else xcd_barrier(xb); } if ((n) == DBG_AFTER) { dbg_dump(p); return; } } } while (0)
__global__ void __launch_bounds__(512, 2) mega(Params p, int ph_lo, int ph_hi) {
    extern __shared__ __attribute__((aligned(16))) unsigned char shm[];
    LAS unsigned char* lds = (LAS unsigned char*)shm;
    cg::grid_group grid = cg::this_grid();
    volatile LAS unsigned* xst = (volatile LAS unsigned*)(lds + LDS_BYTES - 16);
    if (threadIdx.x == 0) { xst[0] = 0u; xst[1] = 0u; }
    __syncthreads();
    if (blockIdx.x == 0) { unsigned* zw = (unsigned*)(p.ws + WS_BAR); for (int i = threadIdx.x; i < (int)(WS_ZERO_BYTES / 4); i += 512) zw[i] = 0u; }
    XcdBarrier xb; xb.bar = (unsigned*)(p.ws + WS_BAR); xb.x = xb_xcc_id(); xb.st = xst;
    PHASE(0, phase_prep_weights(p, lds));
    if (threadIdx.x == 0) (void)xb_add(&xb.bar[XB_XCNT(xb.x)], 1u);
    PHASE(1, phase_modnorm<0>(p, 0, MT, p.norm_ffn1, 0, 1));
    PHASE(2, (run_gemm_gate(p, lds, true), wconv_tail(p, lds, 34 * 44, 1408, 2112)));
    PHASE(3, run_gemm_resid<0>(p, lds));
    PHASE(4, phase_ctxnorm(p, lds));
    PHASE(5, (run_gemm_in(p, lds), wconv_tail(p, lds, 686, 2784, 4448)));
    PHASE(6, phase_gla_a_conv(p, lds));
    PHASE(7, phase_scan(p));
    PHASE(8, phase_gla_c(p, lds));
    PHASE(9, run_gemm_resid<1>(p, lds));
    PHASE(11, (run_gemm_gate(p, lds, false), wconv_tail(p, lds, 32 * 44, 4448, 5152)));
    PHASE(12, run_gemm_resid<2>(p, lds));
}

extern "C" void kernel_launch(void* const* d_in, const int* in_sizes, int n_in, void* d_out, int out_size, void* d_ws, size_t ws_size, hipStream_t stream) {
    static int grid_blocks = 0;
    if (grid_blocks == 0) {
        if (ws_size < WS_END) { fprintf(stderr, "kernel_launch: workspace too small: %zu < %zu\n", ws_size, (size_t)WS_END); grid_blocks = -1; return; }
        int dev = 0, cus = 0, per_cu = 0;
        hipGetDevice(&dev);
        hipDeviceGetAttribute(&cus, hipDeviceAttributeMultiprocessorCount, dev);
        if (hipFuncSetAttribute((const void*)mega, hipFuncAttributeMaxDynamicSharedMemorySize, LDS_BYTES) != hipSuccess) { fprintf(stderr, "kernel_launch: hipFuncSetAttribute failed\n"); }
        if (hipOccupancyMaxActiveBlocksPerMultiprocessor(&per_cu, (const void*)mega, 512, LDS_BYTES) != hipSuccess || per_cu < 1) { fprintf(stderr, "kernel_launch: occupancy query gave %d\n", per_cu); per_cu = 1; }
        (void)hipGetLastError();
        if (per_cu > 1) per_cu = 1;
        grid_blocks = cus * per_cu;
        if (grid_blocks != 256) { fprintf(stderr, "kernel_launch: built for 256 workgroups (256 CUs x 1); got %d: nothing launched\n", grid_blocks); grid_blocks = -1; return; }
        fprintf(stderr, "kernel_launch: grid %d blocks (cus %d)\n", grid_blocks, cus);
    }
    if (grid_blocks < 0) return;
    Params p{};
    const float* const* in = (const float* const*)d_in;
    p.x = in[0]; p.c = in[1]; p.ctx = in[2]; p.c_ctx = in[3]; p.w_mod = in[4]; p.b_mod = in[5]; p.norm_ffn1 = in[6]; p.w_ffn1_in = in[7]; p.w_ffn1_out = in[8];
    p.norm_mix = in[9]; p.w_in = in[10]; p.w_gk2 = in[11]; p.b_gk2 = in[12]; p.gla_norm = in[13]; p.conv_w = in[14]; p.conv_b = in[15]; p.conv_ln_g = in[16];
    p.conv_ln_b = in[17]; p.w_out = in[18]; p.norm_ffn2 = in[19]; p.w_ffn2_in = in[20]; p.w_ffn2_out = in[21]; p.norm_final = in[22];
    p.out = (float*)d_out; p.ws = (unsigned char*)d_ws;
    int ph_lo = 0, ph_hi = NPHASE;
    void* args[] = {&p, &ph_lo, &ph_hi};
    hipError_t e = hipLaunchCooperativeKernel((const void*)mega, dim3(grid_blocks), dim3(512), args, LDS_BYTES, stream);
    if (e != hipSuccess) fprintf(stderr, "kernel_launch: cooperative launch failed: %s (grid %d)\n", hipGetErrorString(e), grid_blocks);
}
```

```cpp
#include <hip/hip_runtime.h>
#include <hip/hip_cooperative_groups.h>
#include <cstdio>
namespace cg = cooperative_groups;

#define LAS __attribute__((address_space(3)))
typedef unsigned short bf16_t;
typedef short bf16x8 __attribute__((ext_vector_type(8)));
typedef float f32x4 __attribute__((ext_vector_type(4)));
typedef float f32x2 __attribute__((ext_vector_type(2)));
typedef unsigned u32x4 __attribute__((ext_vector_type(4)));
typedef unsigned u32x2 __attribute__((ext_vector_type(2)));

constexpr int D = 2048, TL = 8192, TCX = 512, MT = 8704, DFF = 5632, NFF = 11264, NIN = 5152, N3 = 5376, PXW = 3072, NMOD = 18432;
constexpr int NSLOT = 68;
constexpr int LDS_BYTES = 147456;
constexpr int NPHASE = 14;
#ifndef PH_MASK
#define PH_MASK 0x3fff
#endif
#define PH_ON(n) (((PH_MASK) >> (n)) & 1)
#ifndef REP_MASK
#define REP_MASK 0
#endif
#ifndef DBG_ZERO_GLA
#define DBG_ZERO_GLA 0
#endif
#ifndef DBG_ZERO_CONV
#define DBG_ZERO_CONV 0
#endif

constexpr size_t al256(size_t x) { return (x + 255) & ~(size_t)255; }
constexpr size_t WS_WT1 = 0;
constexpr size_t WS_WT2 = WS_WT1 + al256((size_t)NFF * D * 2);
constexpr size_t WS_WT3 = WS_WT2 + al256((size_t)D * DFF * 2);
constexpr size_t WS_WT4 = WS_WT3 + al256((size_t)N3 * D * 2);
constexpr size_t WS_WT5 = WS_WT4 + al256((size_t)D * D * 2);
constexpr size_t WS_WT6 = WS_WT5 + al256((size_t)NFF * D * 2);
constexpr size_t WS_MOD = WS_WT6 + al256((size_t)D * DFF * 2);
constexpr size_t WS_ACT = WS_MOD + al256((size_t)3 * NMOD * 4);
constexpr size_t WS_HID = WS_ACT + al256((size_t)MT * D * 2);
constexpr size_t WS_H1 = WS_HID + al256((size_t)MT * DFF * 2);
constexpr size_t WS_PX = WS_H1 + al256((size_t)MT * D * 4);
constexpr size_t WS_U = WS_PX + al256((size_t)MT * PXW * 2);
constexpr size_t WS_GK = WS_U + al256((size_t)TL * 1024 * 2);
constexpr size_t WS_DEC = WS_GK + al256((size_t)MT * 32 * 4);
constexpr size_t WS_PART = WS_DEC + al256((size_t)2 * 8 * NSLOT * 128 * 4);
constexpr size_t WS_BAR = WS_PART + al256((size_t)11 * TCX * D * 4);
constexpr size_t WS_CNT = WS_BAR + 16384;
constexpr size_t WS_XB = WS_CNT + 3 * 32 * 256;
constexpr size_t WS_BC = WS_XB + al256((size_t)TL * 8 * 4);
constexpr size_t WS_VT = WS_BC + (size_t)2 * 8 * 64 * 64 * 128 * 4;
constexpr size_t WS_END = WS_VT + (size_t)8 * 64 * 256 * 64 * 2;
constexpr size_t WS_ZERO_BYTES = 16384 + 3 * 32 * 256;

struct Params {
    const float* x; const float* c; const float* ctx; const float* c_ctx; const float* w_mod; const float* b_mod;
    const float* norm_ffn1; const float* w_ffn1_in; const float* w_ffn1_out; const float* norm_mix; const float* w_in;
    const float* w_gk2; const float* b_gk2; const float* gla_norm; const float* conv_w; const float* conv_b;
    const float* conv_ln_g; const float* conv_ln_b; const float* w_out; const float* norm_ffn2; const float* w_ffn2_in;
    const float* w_ffn2_out; const float* norm_final;
    float* out; unsigned char* ws;
};

typedef __bf16 bf16x2_t __attribute__((ext_vector_type(2)));
__device__ __forceinline__ unsigned cvt_pk_bf16(float lo, float hi) { f32x2 f = {lo, hi}; bf16x2_t v = __builtin_convertvector(f, bf16x2_t); return __builtin_bit_cast(unsigned, v); }
__device__ __forceinline__ float bf_lo(unsigned u) { return __uint_as_float(u << 16); }
__device__ __forceinline__ float bf_hi(unsigned u) { return __uint_as_float(u & 0xffff0000u); }
__device__ __forceinline__ float wave_sum(float v) {
#pragma unroll
    for (int o = 32; o >= 1; o >>= 1) v += __shfl_xor(v, o, 64);
    return v;
}
__device__ __forceinline__ float silu_f(float x) { return x * __builtin_amdgcn_rcpf(1.f + __expf(-x)); }
__device__ __forceinline__ float sigmoid_f(float x) { return __builtin_amdgcn_rcpf(1.f + __expf(-x)); }
__device__ __forceinline__ int otid() { int t = threadIdx.x; asm volatile("" : "+v"(t)); return t; }
__host__ __device__ __forceinline__ int perm32(int rho) { const int n = rho >> 4, i = rho & 15; return 8 * (i >> 2) + 4 * n + (i & 3); }

constexpr int BM = 256, BK = 64, HALF = 128, HTB = HALF * BK * 2, NXCD = 8, WGM = 4;
__device__ __forceinline__ int lds_byte(int r, int c) { const int st = (r >> 4) * 2 + (c >> 5), rr = r & 15, cc = c & 31, ob = rr * 64 + cc * 2; return st * 1024 + (ob ^ (((ob >> 9) & 1) << 5)); }
__device__ __forceinline__ void stage_rc(int b, int& R, int& C) { const int st = b / 1024, sb = b % 1024, swz = sb ^ (((sb >> 9) & 1) << 5); R = (st >> 1) * 16 + swz / 64; C = (st & 1) * 32 + (swz % 64) / 2; }

struct Unit { int pm, pn, kt0, nt; };
struct Gemm { const bf16_t* A; const bf16_t* Bt; int M, N, K; };
struct Order {
    int nM, nN, nwg, G, c, extra, mode, ntk;
    __device__ void init(int nM_, int nN_, int G_, int c_, int mode_, int ntk_) { nM = nM_; nN = nN_; nwg = nM * nN; G = G_; c = c_; mode = mode_; ntk = ntk_; extra = mode == 1 ? 14 : 0; }
    __device__ bool next(int i, Unit& u) const {
        long L = (long)i * G + c;
        u.kt0 = 0; u.nt = ntk;
        if (mode == 2) {
            const bool has_small = c < 176;
            if (has_small && i == 0) { const int idx = c; u.pm = nM + idx / 88; const int rem = idx % 88; u.pn = rem / 11; u.kt0 = (rem % 11) * 8; u.nt = 8; return true; }
            if ((has_small ? i - 1 : i) != 0) return false;
            L = c;
        }
        if (L >= nwg + extra) return false;
        if (L >= nwg) {
            const int idx = (int)L - nwg;
            if (mode == 1) { u.pm = nM + idx / 7; const int q = idx % 7; u.pn = q < 6 ? q : 20; }
            else return false;
            return true;
        }
        int wgid = (int)L; { const int q = nwg / NXCD, r = nwg % NXCD, xcd = wgid % NXCD, off = wgid / NXCD; wgid = (xcd < r ? xcd * (q + 1) : r * (q + 1) + (xcd - r) * q) + off; }
        const int nig = WGM * nN, gid = wgid / nig, fm = gid * WGM, gsz = (nM - fm) < WGM ? (nM - fm) : WGM;
        u.pm = fm + ((wgid % nig) % gsz); u.pn = (wgid % nig) / gsz; return true;
    }
};


constexpr int L_RS_P = 131072, L_RS_S = 131072 + 4096;
struct RowStats {
    unsigned* xbuf; unsigned* cnt;
    __device__ __forceinline__ void run(const f32x4 (&v)[2][2][4][2], const Unit& u, int wr, int wc, int fr, int fq, LAS unsigned char* lds, int wid, int lane) const {
        LAS float* P = (LAS float*)(lds + L_RS_P);
        LAS float* S = (LAS float*)(lds + L_RS_S);
#pragma unroll
        for (int ai = 0; ai < 2; ++ai)
#pragma unroll
            for (int m = 0; m < 4; ++m) {
                float q = 0.f;
#pragma unroll
                for (int bj = 0; bj < 2; ++bj)
#pragma unroll
                    for (int n = 0; n < 2; ++n) { const f32x4 x = v[ai][bj][m][n]; q += (x[0] * x[0] + x[1] * x[1]) + (x[2] * x[2] + x[3] * x[3]); }
                q += __shfl_xor(q, 16, 64); q += __shfl_xor(q, 32, 64);
                if (fq == 0) P[(ai * HALF + wr * 64 + m * 16 + fr) * 4 + wc] = q;
            }
        __syncthreads();
        const int row = wid * 32 + (lane & 31);
        if (lane < 32) {
            const float tot = (P[row * 4 + 0] + P[row * 4 + 1]) + (P[row * 4 + 2] + P[row * 4 + 3]);
            __hip_atomic_store(xbuf + (size_t)(u.pm * BM + row) * 8 + u.pn, __float_as_uint(tot), __ATOMIC_RELAXED, __HIP_MEMORY_SCOPE_AGENT);
        }
        asm volatile("s_waitcnt vmcnt(0)" ::: "memory");
        if (lane == 0) __hip_atomic_fetch_add(cnt + 64 * u.pm, 1u, __ATOMIC_RELAXED, __HIP_MEMORY_SCOPE_AGENT);
        if (wid == 0) {
            unsigned spins = 0;
            while ((unsigned)__builtin_amdgcn_readfirstlane(__hip_atomic_load(cnt + 64 * u.pm, __ATOMIC_RELAXED, __HIP_MEMORY_SCOPE_AGENT)) < 64u) {
                __builtin_amdgcn_s_sleep(2);
                if (++spins > (1u << 22)) break;
            }
            __builtin_amdgcn_fence(__ATOMIC_ACQUIRE, "agent");
        }
        asm volatile("s_waitcnt vmcnt(0) lgkmcnt(0)" ::: "memory");
        __syncthreads();
        if (lane < 32) {
            const unsigned* slot = xbuf + (size_t)(u.pm * BM + row) * 8; float tot = 0.f;
#pragma unroll
            for (int t = 0; t < 8; ++t) tot += __uint_as_float(__hip_atomic_load(slot + t, __ATOMIC_RELAXED, __HIP_MEMORY_SCOPE_AGENT));
            S[row] = rsqrtf(tot * (1.f / 2048.f) + 1e-6f);
        }
        __syncthreads();
    }
};

struct EpiGate {
    bf16_t* H;
    __device__ __forceinline__ bool defer(const Unit&) const { return false; }
    __device__ __forceinline__ void fused(f32x4 (&)[2][2][4][2], const Unit&, int, int, int, int, LAS unsigned char*, int, int) const {}
    __device__ __forceinline__ void operator()(const f32x4 (&acc)[2][2][4][2], const Unit& u, int wr, int wc, int fr, int fq) const {
        const int row0 = u.pm * BM + wr * 64 + fr, col0 = u.pn * 128 + wc * 32 + 8 * fq;
#pragma unroll
        for (int ai = 0; ai < 2; ++ai)
#pragma unroll
            for (int m = 0; m < 4; ++m) {
                float o[8];
#pragma unroll
                for (int n = 0; n < 2; ++n)
#pragma unroll
                    for (int i = 0; i < 4; ++i) o[n * 4 + i] = silu_f(acc[ai][0][m][n][i]) * acc[ai][1][m][n][i];
                u32x4 pk; pk[0] = cvt_pk_bf16(o[0], o[1]); pk[1] = cvt_pk_bf16(o[2], o[3]); pk[2] = cvt_pk_bf16(o[4], o[5]); pk[3] = cvt_pk_bf16(o[6], o[7]);
                *(u32x4*)(H + (size_t)(row0 + ai * HALF + m * 16) * DFF + col0) = pk;
            }
    }
};
template <int FMODE> struct EpiResid {
    const float* resid_lat; const float* resid_ctx; float* out; const float* mod; int gidx; float gs; float* part;
    RowStats st; const float* gain; int sh_idx, sc_idx; bf16_t* act; float* fout;
    __device__ __forceinline__ bool defer(const Unit& u) const { return FMODE != 0 && u.pm < TL / BM; }
    __device__ __forceinline__ void fused(f32x4 (&acc)[2][2][4][2], const Unit& u, int wr, int wc, int fr, int fq, LAS unsigned char* lds, int wid, int lane) const {
        const int rowt = u.pm * BM; const int set = rowt < 4096 ? 0 : 1;
        const float* md = mod + (size_t)set * NMOD;
        const int row0 = rowt + wr * 64 + fr, col0 = u.pn * BM + wc * 32 + 4 * fq;
        {
            f32x4 gv[2][2];
#pragma unroll
            for (int bj = 0; bj < 2; ++bj)
#pragma unroll
                for (int n = 0; n < 2; ++n) gv[bj][n] = *(const f32x4*)(md + gidx * D + col0 + bj * HALF + n * 16) * gs;
#pragma unroll
            for (int ai = 0; ai < 2; ++ai)
#pragma unroll
                for (int m = 0; m < 4; ++m) {
                    const size_t ro = (size_t)(row0 + ai * HALF + m * 16) * D + col0;
#pragma unroll
                    for (int bj = 0; bj < 2; ++bj)
#pragma unroll
                        for (int n = 0; n < 2; ++n) acc[ai][bj][m][n] = *(const f32x4*)(resid_lat + ro + bj * HALF + n * 16) + gv[bj][n] * acc[ai][bj][m][n];
                    asm volatile("" : "+v"(acc[ai][0][m][0]), "+v"(acc[ai][0][m][1]), "+v"(acc[ai][1][m][0]), "+v"(acc[ai][1][m][1]));
                    if (m & 1) asm volatile("" ::: "memory");
                }
        }
        st.run(acc, u, wr, wc, fr, fq, lds, wid, lane);
        const LAS float* S = (const LAS float*)(lds + L_RS_S);
        f32x4 g2[2][2], sh[2][2];
#pragma unroll
        for (int bj = 0; bj < 2; ++bj)
#pragma unroll
            for (int n = 0; n < 2; ++n) {
                const int c = col0 + bj * HALF + n * 16;
                g2[bj][n] = *(const f32x4*)(gain + c);
                if (FMODE == 1) { g2[bj][n] *= (*(const f32x4*)(md + sc_idx * D + c) + 1.f); sh[bj][n] = *(const f32x4*)(md + sh_idx * D + c); }
                else sh[bj][n] = (f32x4){0.f, 0.f, 0.f, 0.f};
            }
#pragma unroll
        for (int ai = 0; ai < 2; ++ai)
#pragma unroll
            for (int m = 0; m < 4; ++m) {
                const int r = ai * HALF + wr * 64 + m * 16 + fr; const float rs = S[r];
                const size_t ro = (size_t)(rowt + r) * D + col0;
#pragma unroll
                for (int bj = 0; bj < 2; ++bj)
#pragma unroll
                    for (int n = 0; n < 2; ++n) {
                        const f32x4 h = acc[ai][bj][m][n];
                        const f32x4 o = h * rs * g2[bj][n] + sh[bj][n];
                        if (FMODE == 1) {
                            *(f32x4*)(out + ro + bj * HALF + n * 16) = h;
                            u32x2 pk; pk[0] = cvt_pk_bf16(o[0], o[1]); pk[1] = cvt_pk_bf16(o[2], o[3]);
                            *(u32x2*)(act + ro + bj * HALF + n * 16) = pk;
                        } else *(f32x4*)(fout + ro + bj * HALF + n * 16) = o;
                    }
                asm volatile("" ::: "memory");
            }
    }
    __device__ __forceinline__ void operator()(const f32x4 (&acc)[2][2][4][2], const Unit& u, int wr, int wc, int fr, int fq) const {
        if (u.pm >= TL / BM) {
            float* pb = part + (size_t)(u.kt0 >> 3) * TCX * D;
            const int row0 = u.pm * BM - TL + wr * 64 + fr, col0 = u.pn * BM + wc * 32 + 4 * fq;
#pragma unroll
            for (int ai = 0; ai < 2; ++ai)
#pragma unroll
                for (int m = 0; m < 4; ++m)
#pragma unroll
                    for (int bj = 0; bj < 2; ++bj)
#pragma unroll
                        for (int n = 0; n < 2; ++n) *(f32x4*)(pb + (size_t)(row0 + ai * HALF + m * 16) * D + col0 + bj * HALF + n * 16) = acc[ai][bj][m][n];
            return;
        }
        const int rowt = u.pm * BM; const int set = rowt < 4096 ? 0 : (rowt < 8192 ? 1 : 2);
        const float* rb = rowt < TL ? resid_lat : (resid_ctx - (size_t)TL * D);
        const float* mg = mod + (size_t)set * NMOD + gidx * D;
        const int row0 = rowt + wr * 64 + fr, col0 = u.pn * BM + wc * 32 + 4 * fq;
        f32x4 gv[2][2];
#pragma unroll
        for (int bj = 0; bj < 2; ++bj)
#pragma unroll
            for (int n = 0; n < 2; ++n) gv[bj][n] = *(const f32x4*)(mg + col0 + bj * HALF + n * 16) * gs;
#pragma unroll
        for (int ai = 0; ai < 2; ++ai)
#pragma unroll
            for (int m = 0; m < 4; ++m) {
                const size_t ro = (size_t)(row0 + ai * HALF + m * 16) * D + col0;
#pragma unroll
                for (int bj = 0; bj < 2; ++bj)
#pragma unroll
                    for (int n = 0; n < 2; ++n) {
                        const f32x4 r = *(const f32x4*)(rb + ro + bj * HALF + n * 16);
                        *(f32x4*)(out + ro + bj * HALF + n * 16) = r + gv[bj][n] * acc[ai][bj][m][n];
                    }
            }
    }
};
struct EpiIn {
    bf16_t* PX; bf16_t* U; float* GK;
    __device__ __forceinline__ bool defer(const Unit&) const { return false; }
    __device__ __forceinline__ void fused(f32x4 (&)[2][2][4][2], const Unit&, int, int, int, int, LAS unsigned char*, int, int) const {}
    __device__ __forceinline__ void operator()(const f32x4 (&acc)[2][2][4][2], const Unit& u, int wr, int wc, int fr, int fq) const {
        const int row0 = u.pm * BM + wr * 64 + fr;
        if (u.pn < 12) {
            const int col0 = u.pn * BM + wc * 32 + 8 * fq;
#pragma unroll
            for (int ai = 0; ai < 2; ++ai)
#pragma unroll
                for (int m = 0; m < 4; ++m)
#pragma unroll
                    for (int bj = 0; bj < 2; ++bj) {
                        const f32x4 a = acc[ai][bj][m][0], b = acc[ai][bj][m][1];
                        u32x4 pk; pk[0] = cvt_pk_bf16(a[0], a[1]); pk[1] = cvt_pk_bf16(a[2], a[3]); pk[2] = cvt_pk_bf16(b[0], b[1]); pk[3] = cvt_pk_bf16(b[2], b[3]);
                        *(u32x4*)(PX + (size_t)(row0 + ai * HALF + m * 16) * PXW + col0 + bj * HALF) = pk;
                    }
        } else if (u.pn < 20) {
            const int col0 = (u.pn - 12) * 128 + wc * 32 + 8 * fq;
#pragma unroll
            for (int ai = 0; ai < 2; ++ai)
#pragma unroll
                for (int m = 0; m < 4; ++m) {
                    float o[8];
#pragma unroll
                    for (int n = 0; n < 2; ++n)
#pragma unroll
                        for (int i = 0; i < 4; ++i) o[n * 4 + i] = acc[ai][0][m][n][i] * sigmoid_f(acc[ai][1][m][n][i]);
                    u32x4 pk; pk[0] = cvt_pk_bf16(o[0], o[1]); pk[1] = cvt_pk_bf16(o[2], o[3]); pk[2] = cvt_pk_bf16(o[4], o[5]); pk[3] = cvt_pk_bf16(o[6], o[7]);
                    *(u32x4*)(U + (size_t)(row0 + ai * HALF + m * 16) * 1024 + col0) = pk;
                }
        } else {
            if (wc == 0) {
#pragma unroll
                for (int ai = 0; ai < 2; ++ai)
#pragma unroll
                    for (int m = 0; m < 4; ++m)
#pragma unroll
                        for (int n = 0; n < 2; ++n) *(f32x4*)(GK + (size_t)(row0 + ai * HALF + m * 16) * 32 + n * 16 + 4 * fq) = acc[ai][0][m][n];
            }
        }
    }
};

template <class Epi>
__device__ __forceinline__ void gemm_phase(LAS unsigned char* lds, const Gemm g, const Order& S, const Epi& E) {
    const int tid = otid(), wid = __builtin_amdgcn_readfirstlane(tid >> 6), lane = tid & 63, wr = wid >> 2, wc = wid & 3, fr = lane & 15, fq = lane >> 4;
    const int K = g.K;
    unsigned voffA[2];
#pragma unroll
    for (int i = 0; i < 2; ++i) { int R, C; stage_rc(tid * 16 + i * 8192, R, C); voffA[i] = (unsigned)(R * K + C) * 2u; }
    const size_t kstep = (size_t)(BK * 2);
    const size_t hstep = (size_t)HALF * K * 2;
    const size_t tstep = 2 * hstep;
    const unsigned ldsw = (unsigned)wid * 1024u;
    const int aoff = lds_byte(wr * 64 + fr, fq * 8), boff = lds_byte(wc * 32 + fr, fq * 8);
#define PG8_SA(b, h) (((b) * 2 + (h)) * HTB)
#define PG8_SB(b, h) ((4 + (b) * 2 + (h)) * HTB)
#define PG8_STAGE(bufoff, gbase) do { _Pragma("unroll") for (int _i = 0; _i < 2; ++_i) \
        __builtin_amdgcn_global_load_lds((const unsigned*)((const char*)(gbase) + voffA[_i]), (LAS unsigned*)(lds + (bufoff) + ldsw + _i * 8192), 16, 0, 0); } while (0)
#define PG8_LDA(dst, b, h) do { _Pragma("unroll") for (int m = 0; m < 4; ++m) _Pragma("unroll") for (int k = 0; k < 2; ++k) dst[m][k] = *(const LAS bf16x8*)(lds + PG8_SA(b, h) + aoff + m * 2048 + k * 1024); } while (0)
#define PG8_LDB(dst, b, h) do { _Pragma("unroll") for (int n = 0; n < 2; ++n) _Pragma("unroll") for (int k = 0; k < 2; ++k) dst[n][k] = *(const LAS bf16x8*)(lds + PG8_SB(b, h) + boff + n * 2048 + k * 1024); } while (0)
#define PG8_MMA(ai, bj, At, Bt) do { __builtin_amdgcn_s_setprio(1); _Pragma("unroll") for (int m = 0; m < 4; ++m) _Pragma("unroll") for (int n = 0; n < 2; ++n) _Pragma("unroll") for (int k = 0; k < 2; ++k) \
        acc[ai][bj][m][n] = __builtin_amdgcn_mfma_f32_16x16x32_bf16(Bt[n][k], At[m][k], acc[ai][bj][m][n], 0, 0, 0); __builtin_amdgcn_s_setprio(0); } while (0)
#define PG8_WAIT_V(n) asm volatile("s_waitcnt vmcnt(" #n ")" ::: "memory")
#define PG8_WAIT_L(n) asm volatile("s_waitcnt lgkmcnt(" #n ")" ::: "memory")
#define PG8_BAR __builtin_amdgcn_s_barrier()
#define PG8_SCHED __builtin_amdgcn_sched_barrier(0)
    Unit cur, nxt; int ui = 0;
    if (!S.next(0, cur)) return;
    f32x4 acc[2][2][4][2];
#pragma unroll
    for (int a = 0; a < 2; ++a)
#pragma unroll
        for (int b = 0; b < 2; ++b)
#pragma unroll
            for (int m = 0; m < 4; ++m)
#pragma unroll
                for (int n = 0; n < 2; ++n) acc[a][b][m][n] = (f32x4){0.f, 0.f, 0.f, 0.f};
    bf16x8 At[4][2], B0[2][2], B1[2][2];
    const char* cA = (const char*)g.A + (size_t)cur.pm * tstep + (size_t)cur.kt0 * kstep; const char* cB = (const char*)g.Bt + (size_t)cur.pn * tstep + (size_t)cur.kt0 * kstep;
    PG8_STAGE(PG8_SB(0, 0), cB); PG8_STAGE(PG8_SA(0, 0), cA); PG8_STAGE(PG8_SB(0, 1), cB + hstep); PG8_STAGE(PG8_SA(0, 1), cA + hstep);
    if (wr == 1) PG8_BAR;
    PG8_WAIT_V(4); PG8_BAR;
    PG8_STAGE(PG8_SB(1, 0), cB + kstep); PG8_STAGE(PG8_SA(1, 0), cA + kstep); PG8_STAGE(PG8_SB(1, 1), cB + hstep + kstep);
    PG8_WAIT_V(6); PG8_BAR;
    for (;;) {
        const bool has_next = S.next(ui + 1, nxt);
        const char* nA = has_next ? (const char*)g.A + (size_t)nxt.pm * tstep + (size_t)nxt.kt0 * kstep : cA; const char* nB = has_next ? (const char*)g.Bt + (size_t)nxt.pn * tstep + (size_t)nxt.kt0 * kstep : cB;
        const int nt = cur.nt;
        for (int t = 0; t < nt; t += 2) {
            const bool last = (t == nt - 2);
            const char* a1 = cA + (size_t)(t + 1) * kstep;
            const char* a2 = last ? nA : cA + (size_t)(t + 2) * kstep; const char* b2 = last ? nB : cB + (size_t)(t + 2) * kstep;
            const char* a3 = a2 + kstep; const char* b3 = b2 + kstep;
            PG8_LDB(B0, 0, 0); PG8_SCHED; PG8_LDA(At, 0, 0); PG8_STAGE(PG8_SA(1, 1), a1 + hstep);
            PG8_WAIT_L(8); PG8_BAR; PG8_WAIT_L(0); PG8_MMA(0, 0, At, B0); PG8_BAR; PG8_SCHED;
            PG8_LDB(B1, 0, 1); PG8_STAGE(PG8_SB(0, 0), b2);
            PG8_BAR; PG8_WAIT_L(0); PG8_MMA(0, 1, At, B1); PG8_BAR;
            PG8_LDA(At, 0, 1); PG8_STAGE(PG8_SA(0, 0), a2);
            PG8_BAR; PG8_WAIT_L(0); PG8_MMA(1, 0, At, B0); PG8_BAR; PG8_SCHED;
            PG8_STAGE(PG8_SB(0, 1), b2 + hstep);
            PG8_WAIT_V(6); PG8_BAR; PG8_MMA(1, 1, At, B1); PG8_BAR;
            PG8_LDB(B0, 1, 0); PG8_SCHED; PG8_LDA(At, 1, 0); PG8_STAGE(PG8_SA(0, 1), a2 + hstep);
            PG8_WAIT_L(8); PG8_BAR; PG8_WAIT_L(0); PG8_MMA(0, 0, At, B0); PG8_BAR; PG8_SCHED;
            PG8_LDB(B1, 1, 1); PG8_STAGE(PG8_SB(1, 0), b3);
            PG8_BAR; PG8_WAIT_L(0); PG8_MMA(0, 1, At, B1); PG8_BAR;
            PG8_LDA(At, 1, 1); PG8_STAGE(PG8_SA(1, 0), a3);
            PG8_BAR; PG8_WAIT_L(0); PG8_MMA(1, 0, At, B0); PG8_BAR; PG8_SCHED;
            PG8_STAGE(PG8_SB(1, 1), b3 + hstep);
            PG8_WAIT_V(6); PG8_BAR; PG8_MMA(1, 1, At, B1); PG8_BAR;
        }
        if (!E.defer(cur)) E(acc, cur, wr, wc, fr, fq);
        if (!has_next) break;
#pragma unroll
        for (int a = 0; a < 2; ++a)
#pragma unroll
            for (int b = 0; b < 2; ++b)
#pragma unroll
                for (int m = 0; m < 4; ++m)
#pragma unroll
                    for (int n = 0; n < 2; ++n) acc[a][b][m][n] = (f32x4){0.f, 0.f, 0.f, 0.f};
        cur = nxt; cA = nA; cB = nB; ++ui;
    }
    PG8_WAIT_V(0);
    if (wr == 0) PG8_BAR;
    PG8_BAR;
    if (E.defer(cur)) E.fused(acc, cur, wr, wc, fr, fq, lds, wid, lane);
#undef PG8_SA
#undef PG8_SB
#undef PG8_STAGE
#undef PG8_LDA
#undef PG8_LDB
#undef PG8_MMA
#undef PG8_WAIT_V
#undef PG8_WAIT_L
#undef PG8_BAR
#undef PG8_SCHED
}

__device__ __forceinline__ void gemv_item(const Params& p, LAS unsigned char* lds, int nt) {
    const int tid = otid();
    LAS float* sv = (LAS float*)lds;
    LAS float* red = sv + 3 * 2048;
    {
        float cvv[12];
#pragma unroll
        for (int q = 0; q < 12; ++q) { const int k = (tid + 512 * q) & 2047; cvv[q] = (q >> 2) < 2 ? p.c[(q >> 2) * 2048 + k] : p.c_ctx[k]; }
#pragma unroll
        for (int q = 0; q < 12; ++q) sv[tid + 512 * q] = cvv[q] / (1.f + __expf(-cvv[q]));
    }
    __syncthreads();
    const int cg4 = tid & 31, kl = tid >> 5;
    const float* wp = p.w_mod + (size_t)kl * NMOD + nt * 128 + cg4 * 4;
    f32x4 a0 = {0.f, 0.f, 0.f, 0.f}, a1 = a0, a2 = a0;
#pragma unroll 8
    for (int k = kl; k < 2048; k += 16) {
        const f32x4 w = __builtin_nontemporal_load((const f32x4*)wp); wp += (size_t)16 * NMOD;
        const float s0 = sv[k], s1 = sv[2048 + k], s2 = sv[4096 + k];
        a0 += w * s0; a1 += w * s1; a2 += w * s2;
    }
#pragma unroll
    for (int i = 0; i < 4; ++i) { red[(kl * 3 + 0) * 128 + cg4 * 4 + i] = a0[i]; red[(kl * 3 + 1) * 128 + cg4 * 4 + i] = a1[i]; red[(kl * 3 + 2) * 128 + cg4 * 4 + i] = a2[i]; }
    __syncthreads();
    if (tid < 384) {
        const int r = tid >> 7, col = tid & 127; float s = 0.f;
#pragma unroll
        for (int q = 0; q < 16; ++q) s += red[(q * 3 + r) * 128 + col];
        float* MOD = (float*)(p.ws + WS_MOD);
        MOD[r * NMOD + nt * 128 + col] = s + p.b_mod[nt * 128 + col];
    }
}

struct WcDesc { const float* src; bf16_t* dst; int K, Nsrc, perm, nvalid; };
__device__ __forceinline__ WcDesc wconv_decode(const Params& p, int it) {
    int w, loc;
    if (it < 1408) { w = 0; loc = it; } else if (it < 2112) { w = 1; loc = it - 1408; } else if (it < 2784) { w = 2; loc = it - 2112; }
    else if (it < 3040) { w = 3; loc = it - 2784; } else if (it < 4448) { w = 4; loc = it - 3040; } else { w = 5; loc = it - 4448; }
    const float* src; bf16_t* dst; int K, Nsrc, nR;
    switch (w) {
        case 0: src = p.w_ffn1_in; dst = (bf16_t*)(p.ws + WS_WT1); K = D; Nsrc = NFF; nR = 88; break;
        case 1: src = p.w_ffn1_out; dst = (bf16_t*)(p.ws + WS_WT2); K = DFF; Nsrc = D; nR = 16; break;
        case 2: src = p.w_in; dst = (bf16_t*)(p.ws + WS_WT3); K = D; Nsrc = NIN; nR = 42; break;
        case 3: src = p.w_out; dst = (bf16_t*)(p.ws + WS_WT4); K = D; Nsrc = D; nR = 16; break;
        case 4: src = p.w_ffn2_in; dst = (bf16_t*)(p.ws + WS_WT5); K = D; Nsrc = NFF; nR = 88; break;
        default: src = p.w_ffn2_out; dst = (bf16_t*)(p.ws + WS_WT6); K = DFF; Nsrc = D; nR = 16; break;
    }
    const int R = loc % nR, kt = loc / nR, k0 = kt * 128;
    int sbase, perm, nvalid = 128;
    if (w == 0 || w == 4) { sbase = (R & 1) * DFF + 128 * (R >> 1); perm = 1; }
    else if (w == 2) {
        if (R < 24) { sbase = 128 * R + (R >= 12 ? 32 : 0); perm = 1; }
        else if (R < 40) { const int q = R - 24; sbase = 3104 + (q & 1) * 1024 + 128 * (q >> 1); perm = 1; }
        else if (R == 40) { sbase = 1536; perm = 0; nvalid = 32; }
        else { sbase = 0; perm = 0; nvalid = 0; }
    } else { sbase = 128 * R; perm = 0; }
    WcDesc d; d.src = src + (size_t)k0 * Nsrc + sbase; d.dst = dst + (size_t)(128 * R) * K + k0; d.K = K; d.Nsrc = Nsrc; d.perm = perm; d.nvalid = nvalid;
    return d;
}
__device__ __forceinline__ void wconv_load(const WcDesc& d, int tid, f32x4 (&v)[2][4]) {
    const int cb = tid & 31;
#pragma unroll
    for (int iter = 0; iter < 2; ++iter) {
        const int kb = (tid >> 5) + 16 * iter;
#pragma unroll
        for (int kr = 0; kr < 4; ++kr) {
            if (4 * cb < d.nvalid) v[iter][kr] = __builtin_nontemporal_load((const f32x4*)(d.src + (size_t)(4 * kb + kr) * d.Nsrc + 4 * cb));
            else v[iter][kr] = (f32x4){0.f, 0.f, 0.f, 0.f};
        }
    }
}
__device__ __forceinline__ void wconv_lds(LAS unsigned char* lds, int tid, const f32x4 (&v)[2][4]) {
    const int cb = tid & 31;
#pragma unroll
    for (int iter = 0; iter < 2; ++iter) {
        const int kb = (tid >> 5) + 16 * iter;
#pragma unroll
        for (int ci = 0; ci < 4; ++ci) {
            u32x2 pk; pk[0] = cvt_pk_bf16(v[iter][0][ci], v[iter][1][ci]); pk[1] = cvt_pk_bf16(v[iter][2][ci], v[iter][3][ci]);
            *(LAS u32x2*)(lds + (4 * cb + ci) * 264 + 8 * kb) = pk;
        }
    }
}
__device__ __forceinline__ void wconv_out(const WcDesc& d, LAS unsigned char* lds, int tid) {
#pragma unroll
    for (int iter = 0; iter < 4; ++iter) {
        const int rr = (tid >> 4) + 32 * iter, kg = tid & 15;
        const int cc = d.perm ? ((rr & ~31) + perm32(rr & 31)) : rr;
        const u32x2 lo = *(const LAS u32x2*)(lds + cc * 264 + 16 * kg), hi = *(const LAS u32x2*)(lds + cc * 264 + 16 * kg + 8);
        u32x4 o; o[0] = lo[0]; o[1] = lo[1]; o[2] = hi[0]; o[3] = hi[1];
        *(u32x4*)(d.dst + (size_t)rr * d.K + 8 * kg) = o;
    }
}
template <class MAP>
__device__ __forceinline__ void wconv_run(const Params& p, LAS unsigned char* lds, int first, int stride, int nloc, MAP map) {
    const int tid = otid();
    if (first >= nloc) return;
    f32x4 va[2][4], vb[2][4];
    WcDesc da = wconv_decode(p, map(first)); wconv_load(da, tid, va);
    int itb = first + stride; bool hb = itb < nloc; WcDesc db = da;
    if (hb) { db = wconv_decode(p, map(itb)); wconv_load(db, tid, vb); }
    for (;;) {
        wconv_lds(lds, tid, va);
        __syncthreads();
        const int itc = itb + stride; const bool hc = hb && itc < nloc; WcDesc dc = da;
        if (hc) { dc = wconv_decode(p, map(itc)); wconv_load(dc, tid, va); }
        wconv_out(da, lds, tid);
        __syncthreads();
        if (!hb) break;
        wconv_lds(lds, tid, vb);
        __syncthreads();
        const int itd = itc + stride; const bool hd = hc && itd < nloc; WcDesc dd = db;
        if (hd) { dd = wconv_decode(p, map(itd)); wconv_load(dd, tid, vb); }
        wconv_out(db, lds, tid);
        __syncthreads();
        if (!hc) break;
        da = dc; db = dd; itb = itd; hb = hd;
    }
}

__device__ __forceinline__ void phase_prep_weights(const Params& p, LAS unsigned char* lds) {
    for (int it = blockIdx.x; it < 128; it += gridDim.x) { gemv_item(p, lds, it); __syncthreads(); }
    const int G = gridDim.x; const int c = (int)((blockIdx.x + G - (128 % G)) % G);
    wconv_run(p, lds, c, G, 1408 + 672, [](int i) { return i < 1408 ? i : i - 1408 + 2112; });
}
__device__ __forceinline__ void wconv_tail(const Params& p, LAS unsigned char* lds, int nunits, int it0, int it1) {
    const int G = gridDim.x, first_idle = nunits % G, nidle = G - first_idle, c = blockIdx.x;
    if (c >= first_idle) wconv_run(p, lds, c - first_idle, nidle, it1 - it0, [it0](int i) { return i + it0; });
}

template <int MODE>
__device__ __forceinline__ void phase_modnorm(const Params& p, int row_begin, int nrows, const float* gain, int shift_idx, int scale_idx) {
    const int tid_ = otid(); const int wave = tid_ >> 6, lane = tid_ & 63;
    const float* MOD = (const float*)(p.ws + WS_MOD);
    const float* H1 = (const float*)(p.ws + WS_H1);
    bf16_t* ACT = (bf16_t*)(p.ws + WS_ACT);
    for (int row = row_begin + blockIdx.x * 8 + wave; row < nrows; row += gridDim.x * 8) {
        const float* src = MODE == 0 ? (row < TL ? p.x + (size_t)row * D : p.ctx + (size_t)(row - TL) * D) : (row < TL ? H1 + (size_t)row * D : p.ctx + (size_t)(row - TL) * D);
        const int set = row < 4096 ? 0 : (row < 8192 ? 1 : 2);
        const float* md = MOD + (size_t)set * NMOD;
        f32x4 v[8]; float ss = 0.f;
#pragma unroll
        for (int i = 0; i < 8; ++i) {
            v[i] = *(const f32x4*)(src + (i * 64 + lane) * 4);
            if (MODE == 1 && row >= TL) {
                const float* pp = (const float*)(p.ws + WS_PART) + (size_t)(row - TL) * D + (i * 64 + lane) * 4;
                f32x4 a = *(const f32x4*)pp;
#pragma unroll
                for (int ks = 1; ks < 11; ++ks) a += *(const f32x4*)(pp + (size_t)ks * TCX * D);
                v[i] += a * (*(const f32x4*)(md + 2 * D + (i * 64 + lane) * 4)) * 0.5f;
            }
            ss += v[i][0] * v[i][0] + v[i][1] * v[i][1] + v[i][2] * v[i][2] + v[i][3] * v[i][3]; }
        f32x4 gq[8], scq[8], shq[8];
#pragma unroll
        for (int i = 0; i < 8; ++i) {
            const int col = (i * 64 + lane) * 4;
            gq[i] = *(const f32x4*)(gain + col); scq[i] = *(const f32x4*)(md + scale_idx * D + col); shq[i] = *(const f32x4*)(md + shift_idx * D + col);
        }
        ss = wave_sum(ss);
        const float rs = rsqrtf(ss * (1.f / 2048.f) + 1e-6f);
#pragma unroll
        for (int i = 0; i < 8; ++i) {
            const int col = (i * 64 + lane) * 4;
            const f32x4 o = v[i] * rs * gq[i] * (scq[i] + 1.f) + shq[i];
            u32x2 pk; pk[0] = cvt_pk_bf16(o[0], o[1]); pk[1] = cvt_pk_bf16(o[2], o[3]);
            *(u32x2*)(ACT + (size_t)row * D + col) = pk;
        }
    }
}
__device__ __forceinline__ void phase_ctxnorm(const Params& p, LAS unsigned char* lds) {
    const int tid_ = otid(); const int wave = tid_ >> 6, lane = tid_ & 63, r = wave >> 2, qtr = wave & 3;
    const float* md = (const float*)(p.ws + WS_MOD) + (size_t)2 * NMOD;
    const float* PART = (const float*)(p.ws + WS_PART);
    bf16_t* ACT = (bf16_t*)(p.ws + WS_ACT);
    LAS float* red = (LAS float*)lds;
    for (int rp = blockIdx.x; rp < TCX / 2; rp += gridDim.x) {
        const int rc = rp * 2 + r;
        f32x4 v[2], a[2], m2[2]; f32x4 pr[2][11];
#pragma unroll
        for (int i = 0; i < 2; ++i) {
            const int col = qtr * 512 + (i * 64 + lane) * 4;
            v[i] = *(const f32x4*)(p.ctx + (size_t)rc * D + col);
            m2[i] = *(const f32x4*)(md + 2 * D + col);
#pragma unroll
            for (int ks = 0; ks < 11; ++ks) pr[i][ks] = *(const f32x4*)(PART + ((size_t)ks * TCX + rc) * D + col);
        }
        float ss = 0.f;
#pragma unroll
        for (int i = 0; i < 2; ++i) {
            a[i] = pr[i][0];
#pragma unroll
            for (int ks = 1; ks < 11; ++ks) a[i] += pr[i][ks];
            v[i] += a[i] * m2[i] * 0.5f;
            ss += v[i][0] * v[i][0] + v[i][1] * v[i][1] + v[i][2] * v[i][2] + v[i][3] * v[i][3];
        }
        ss = wave_sum(ss);
        if (lane == 0) red[wave] = ss;
        __syncthreads();
        const float tot = (red[r * 4] + red[r * 4 + 1]) + (red[r * 4 + 2] + red[r * 4 + 3]);
        const float rs = rsqrtf(tot * (1.f / 2048.f) + 1e-6f);
#pragma unroll
        for (int i = 0; i < 2; ++i) {
            const int col = qtr * 512 + (i * 64 + lane) * 4;
            const f32x4 g = *(const f32x4*)(p.norm_mix + col), sc = *(const f32x4*)(md + 4 * D + col), sh = *(const f32x4*)(md + 3 * D + col);
            const f32x4 o = v[i] * rs * g * (sc + 1.f) + sh;
            u32x2 pk; pk[0] = cvt_pk_bf16(o[0], o[1]); pk[1] = cvt_pk_bf16(o[2], o[3]);
            *(u32x2*)(ACT + (size_t)(TL + rc) * D + col) = pk;
        }
        __syncthreads();
    }
}
__device__ __forceinline__ void phase_final(const Params& p) {
    const int tid_ = otid(); const int wave = tid_ >> 6, lane = tid_ & 63;
    const float* H1 = (const float*)(p.ws + WS_H1);
    for (int row = blockIdx.x * 8 + wave; row < TL; row += gridDim.x * 8) {
        const float* src = H1 + (size_t)row * D;
        f32x4 v[8]; float ss = 0.f;
#pragma unroll
        for (int i = 0; i < 8; ++i) { v[i] = *(const f32x4*)(src + (i * 64 + lane) * 4); ss += v[i][0] * v[i][0] + v[i][1] * v[i][1] + v[i][2] * v[i][2] + v[i][3] * v[i][3]; }
        ss = wave_sum(ss);
        const float rs = rsqrtf(ss * (1.f / 2048.f) + 1e-6f);
#pragma unroll
        for (int i = 0; i < 8; ++i) {
            const int col = (i * 64 + lane) * 4;
            const f32x4 g = *(const f32x4*)(p.norm_final + col);
            *(f32x4*)(p.out + (size_t)row * D + col) = v[i] * rs * g;
        }
    }
}

constexpr int L_GKS = 0;
constexpr int L_BC = 8192;
constexpr int L_VT = L_BC + 33024;
constexpr int L_T0 = L_VT + 36864;
constexpr int L_QS = L_T0, L_KS = L_T0 + 17408, L_QE = L_T0 + 2 * 17408, L_ATT = L_T0 + 3 * 17408, L_RED = L_ATT + 9216;
constexpr int L_TOT = L_RED + 2048;
static_assert(L_TOT + 4096 <= LDS_BYTES - 16, "LDS");

__device__ __forceinline__ void gla_stage_common(const Params& p, LAS unsigned char* lds, int row0, int h) {
    const int tid = otid();
    const float* GK = (const float*)(p.ws + WS_GK);
    const bf16_t* PX = (const bf16_t*)(p.ws + WS_PX);
    const int t4 = tid & 15, eg = tid >> 4;
    const f32x4 gkv = *(const f32x4*)(GK + (size_t)(row0 + (tid >> 3)) * 32 + (tid & 7) * 4);
    u32x4 vv[4];
#pragma unroll
    for (int i = 0; i < 4; ++i) vv[i] = *(const u32x4*)(PX + (size_t)(row0 + 4 * t4 + i) * PXW + 512 + h * 256 + eg * 8);
    asm volatile("" :: "v"(gkv), "v"(vv[0]), "v"(vv[1]), "v"(vv[2]), "v"(vv[3]));
    *(LAS f32x4*)(lds + L_GKS + ((tid >> 3) * 32 + (tid & 7) * 4) * 4) = gkv;
#pragma unroll
    for (int k = 0; k < 4; ++k) {
        u32x2 lo, hi;
        lo[0] = (vv[0][k] & 0xffffu) | (vv[1][k] << 16); lo[1] = (vv[2][k] & 0xffffu) | (vv[3][k] << 16);
        hi[0] = (vv[0][k] >> 16) | (vv[1][k] & 0xffff0000u); hi[1] = (vv[2][k] >> 16) | (vv[3][k] & 0xffff0000u);
        *(LAS u32x2*)(lds + L_VT + ((eg * 8 + 2 * k) * 72 + 4 * t4) * 2) = lo;
        *(LAS u32x2*)(lds + L_VT + ((eg * 8 + 2 * k + 1) * 72 + 4 * t4) * 2) = hi;
    }
}
__device__ __forceinline__ void gla_load_w2(const Params& p, int h, int d, int tid, float (&w2r)[16], float& b2) {
    const int j = tid & 127;
#pragma unroll
    for (int r = 0; r < 16; ++r) w2r[r] = p.w_gk2[(size_t)(d * 16 + r) * 512 + h * 128 + j];
    b2 = p.b_gk2[d * 512 + h * 128 + j];
}
__device__ __forceinline__ void gla_logdecay16w(LAS unsigned char* lds, int d, int tid, const float (&w2r)[16], float b2, float (&ld)[16]) {
    const int seg = tid >> 7;
    LAS float* gks = (LAS float*)(lds + L_GKS);
#pragma unroll
    for (int tt = 0; tt < 16; ++tt) {
        const int t = 16 * seg + tt;
        float z = b2;
#pragma unroll
        for (int r4 = 0; r4 < 4; ++r4) {
            const f32x4 gv = *(const LAS f32x4*)(gks + t * 32 + d * 16 + r4 * 4);
            z += gv[0] * w2r[r4 * 4] + gv[1] * w2r[r4 * 4 + 1] + gv[2] * w2r[r4 * 4 + 2] + gv[3] * w2r[r4 * 4 + 3];
        }
        const float e2 = __builtin_amdgcn_exp2f(fabsf(z) * -1.4426950408889634f);
        ld[tt] = fminf(z, 0.f) * (1.f / 16.f) - 0.04332169878499658f * __builtin_amdgcn_logf(1.f + e2);
    }
}
__device__ __forceinline__ void gla_logdecay16(const Params& p, LAS unsigned char* lds, int h, int d, int tid, float (&ld)[16]) {
    float w2r[16], b2; gla_load_w2(p, h, d, tid, w2r, b2); gla_logdecay16w(lds, d, tid, w2r, b2, ld);
}
__device__ __forceinline__ void gla_cumdecay(const Params& p, LAS unsigned char* lds, int h, int d) {
    const int tid = otid(), j = tid & 127, seg = tid >> 7;
    LAS float* bc = (LAS float*)(lds + L_BC);
    LAS float* tot = (LAS float*)(lds + L_TOT);
    float ld[16];
    gla_logdecay16(p, lds, h, d, tid, ld);
    float run = 0.f;
    if (d == 0) {
#pragma unroll
        for (int tt = 0; tt < 16; ++tt) { run += ld[tt]; ld[tt] = run; }
    } else {
#pragma unroll
        for (int tt = 15; tt >= 0; --tt) { run += ld[tt]; ld[tt] = run; }
    }
    tot[seg * 128 + j] = run;
    __syncthreads();
    float off = 0.f;
#pragma unroll
    for (int sg = 0; sg < 4; ++sg) { const float tv = tot[sg * 128 + j]; const bool use = d == 0 ? (sg < seg) : (sg > seg); off += use ? tv : 0.f; }
#pragma unroll
    for (int tt = 0; tt < 16; ++tt) bc[(16 * seg + tt) * 129 + j] = ld[tt] + off;
    __syncthreads();
}

__device__ __forceinline__ void gla_a_item(const Params& p, LAS unsigned char* lds, int item, int dsel) {
    const int tid = otid(), wid = tid >> 6, lane = tid & 63, fr = lane & 15, fq = lane >> 4;
    const int bh = item / NSLOT, slot = item % NSLOT, b = bh >> 2, h = bh & 3;
    const int row0 = slot < 4 ? TL + b * 256 + slot * 64 : b * 4096 + (slot - 4) * 64;
    const bf16_t* PX = (const bf16_t*)(p.ws + WS_PX);
    bf16_t* KVT = (bf16_t*)(p.ws + WS_HID);
    float* DEC = (float*)(p.ws + WS_DEC);
    LAS float* tot = (LAS float*)(lds + L_TOT);
    const int j = tid & 127, seg = tid >> 7;
    gla_stage_common(p, lds, row0, h);
    float kf[16];
#pragma unroll
    for (int tt = 0; tt < 16; ++tt) kf[tt] = bf_lo((unsigned)PX[(size_t)(row0 + 16 * seg + tt) * PXW + h * 128 + j]);
    float w2f[16], w2b[16], b2f, b2b;
    gla_load_w2(p, h, 0, tid, w2f, b2f); gla_load_w2(p, h, 1, tid, w2b, b2b);
    __syncthreads();
    const bool do_f = dsel != 2, do_b = dsel != 1;
    float lf[16], lb[16];
    if (do_f) gla_logdecay16w(lds, 0, tid, w2f, b2f, lf); else {
#pragma unroll
        for (int q = 0; q < 16; ++q) lf[q] = 0.f; }
    if (do_b) gla_logdecay16w(lds, 1, tid, w2b, b2b, lb); else {
#pragma unroll
        for (int q = 0; q < 16; ++q) lb[q] = 0.f; }
    float tf = 0.f, tb = 0.f;
#pragma unroll
    for (int tt = 15; tt >= 0; --tt) { const float v = lf[tt]; lf[tt] = tf; tf += v; }
#pragma unroll
    for (int tt = 0; tt < 16; ++tt) { const float v = lb[tt]; lb[tt] = tb; tb += v; }
    tot[seg * 128 + j] = tf; tot[512 + seg * 128 + j] = tb;
    __syncthreads();
    float of = 0.f, ob = 0.f, sf = 0.f, sb = 0.f;
#pragma unroll
    for (int sg = 0; sg < 4; ++sg) { const float a = tot[sg * 128 + j], c = tot[512 + sg * 128 + j]; sf += a; sb += c; of += sg > seg ? a : 0.f; ob += sg < seg ? c : 0.f; }
    if (do_f) {
        u32x4 w0, w1;
#pragma unroll
        for (int q = 0; q < 4; ++q) {
            w0[q] = cvt_pk_bf16(kf[2 * q] * __expf(lf[2 * q] + of), kf[2 * q + 1] * __expf(lf[2 * q + 1] + of));
            w1[q] = cvt_pk_bf16(kf[8 + 2 * q] * __expf(lf[8 + 2 * q] + of), kf[8 + 2 * q + 1] * __expf(lf[8 + 2 * q + 1] + of));
        }
        *(LAS u32x4*)(lds + L_T0 + (j * 72 + 16 * seg) * 2) = w0; *(LAS u32x4*)(lds + L_T0 + (j * 72 + 16 * seg + 8) * 2) = w1;
    }
    if (do_b) {
        u32x4 w2, w3;
#pragma unroll
        for (int q = 0; q < 4; ++q) {
            w2[q] = cvt_pk_bf16(kf[2 * q] * __expf(lb[2 * q] + ob), kf[2 * q + 1] * __expf(lb[2 * q + 1] + ob));
            w3[q] = cvt_pk_bf16(kf[8 + 2 * q] * __expf(lb[8 + 2 * q] + ob), kf[8 + 2 * q + 1] * __expf(lb[8 + 2 * q + 1] + ob));
        }
        *(LAS u32x4*)(lds + L_T0 + 18432 + (j * 72 + 16 * seg) * 2) = w2; *(LAS u32x4*)(lds + L_T0 + 18432 + (j * 72 + 16 * seg + 8) * 2) = w3;
    }
    if (slot >= 4) {
        float bef = 0.f, aft = 0.f;
#pragma unroll
        for (int sg = 0; sg < 4; ++sg) { bef += sg < seg ? tot[sg * 128 + j] : 0.f; aft += sg > seg ? tot[512 + sg * 128 + j] : 0.f; }
        float* bcf = (float*)(p.ws + WS_BC) + (((size_t)(0 * 8 + bh) * 64 + (slot - 4)) * 64 + 16 * seg) * 128 + j;
        float* bcb = (float*)(p.ws + WS_BC) + (((size_t)(1 * 8 + bh) * 64 + (slot - 4)) * 64 + 16 * seg) * 128 + j;
#pragma unroll
        for (int tt = 0; tt < 16; ++tt) { if (do_f) bcf[tt * 128] = (tf - lf[tt]) + bef; if (do_b) bcb[tt * 128] = (tb - lb[tt]) + aft; }
        bf16_t* vtg = (bf16_t*)(p.ws + WS_VT) + ((size_t)bh * 64 + (slot - 4)) * 256 * 64;
        if (do_f)
#pragma unroll
        for (int it = 0; it < 4; ++it) {
            const int id = tid + 512 * it, e = id >> 3, cq = id & 7;
            *(u32x4*)(vtg + e * 64 + cq * 8) = *(const LAS u32x4*)(lds + L_VT + e * 144 + cq * 16);
        }
    }
    if (seg == 0 && do_f) DEC[((size_t)(0 * 8 + bh) * NSLOT + slot) * 128 + j] = __expf(sf);
    if (seg == 1 && do_b) DEC[((size_t)(1 * 8 + bh) * NSLOT + slot) * 128 + j] = __expf(sb);
    __syncthreads();
    for (int d = 0; d < 2; ++d) {
        if (d == 0 ? !do_f : !do_b) continue;
        f32x4 acc[2][8];
#pragma unroll
        for (int et = 0; et < 2; ++et)
#pragma unroll
            for (int jt = 0; jt < 8; ++jt) acc[et][jt] = (f32x4){0.f, 0.f, 0.f, 0.f};
#pragma unroll
        for (int ks = 0; ks < 2; ++ks) {
            bf16x8 bv[2];
#pragma unroll
            for (int et = 0; et < 2; ++et) bv[et] = *(const LAS bf16x8*)(lds + L_VT + (32 * wid + 16 * et + fr) * 144 + (ks * 32 + fq * 8) * 2);
#pragma unroll
            for (int jt = 0; jt < 8; ++jt) {
                const bf16x8 av = *(const LAS bf16x8*)(lds + L_T0 + d * 18432 + (16 * jt + fr) * 144 + (ks * 32 + fq * 8) * 2);
#pragma unroll
                for (int et = 0; et < 2; ++et) acc[et][jt] = __builtin_amdgcn_mfma_f32_16x16x32_bf16(av, bv[et], acc[et][jt], 0, 0, 0);
            }
        }
        bf16_t* kvb = KVT + ((size_t)(d * 8 + bh) * NSLOT + slot) * 32768;
#pragma unroll
        for (int et = 0; et < 2; ++et)
#pragma unroll
            for (int jt = 0; jt < 8; ++jt) {
                u32x2 pk; pk[0] = cvt_pk_bf16(acc[et][jt][0], acc[et][jt][1]); pk[1] = cvt_pk_bf16(acc[et][jt][2], acc[et][jt][3]);
                *(u32x2*)(kvb + (32 * wid + 16 * et + fr) * 128 + 16 * jt + 4 * fq) = pk;
            }
    }
}

template <int NT>
__device__ __forceinline__ void conv_window(const bf16_t* ubase, size_t stride_el, int p0, const LAS float* cwl, float (*y)[8]) {
    constexpr int PFD = 8;
    float wv[NT][8]; u32x4 pf[PFD];
    const bf16_t* ptr = ubase + (ptrdiff_t)p0 * (ptrdiff_t)stride_el;
#pragma unroll
    for (int q = 0; q < NT; ++q) {
        u32x4 v = *(const u32x4*)ptr; ptr += stride_el;
        const int pos = p0 + q; if (pos < 0 || pos > 63) v = (u32x4){0u, 0u, 0u, 0u};
#pragma unroll
        for (int i = 0; i < 4; ++i) { wv[q][2 * i] = bf_lo(v[i]); wv[q][2 * i + 1] = bf_hi(v[i]); }
    }
#pragma unroll
    for (int q = 0; q < PFD; ++q) { pf[q] = *(const u32x4*)ptr; ptr += stride_el; }
#pragma unroll 1
    for (int j0 = 0; j0 < 32; j0 += 8) {
#pragma unroll
        for (int jj = 0; jj < 8; ++jj) {
            const int j = j0 + jj;
            const f32x4 c0 = *(const LAS f32x4*)(cwl + j * 1024), c1 = *(const LAS f32x4*)(cwl + j * 1024 + 4);
#pragma unroll
            for (int tk = 0; tk < NT; ++tk) {
                const float (&w)[8] = wv[(tk + jj) % NT];
                y[tk][0] += w[0] * c0[0]; y[tk][1] += w[1] * c0[1]; y[tk][2] += w[2] * c0[2]; y[tk][3] += w[3] * c0[3];
                y[tk][4] += w[4] * c1[0]; y[tk][5] += w[5] * c1[1]; y[tk][6] += w[6] * c1[2]; y[tk][7] += w[7] * c1[3];
            }
            {
                u32x4 v = pf[jj];
                const int pos = p0 + NT + j; if (pos < 0 || pos > 63) v = (u32x4){0u, 0u, 0u, 0u};
                float (&w)[8] = wv[jj % NT];
#pragma unroll
                for (int i = 0; i < 4; ++i) { w[2 * i] = bf_lo(v[i]); w[2 * i + 1] = bf_hi(v[i]); }
            }
            pf[jj] = *(const u32x4*)ptr; ptr += stride_el;
        }
    }
}
__device__ __forceinline__ void conv_item(const Params& p, LAS unsigned char* lds, int item) {
    const int tid = otid(), wid = tid >> 6;
    const int b = item >> 7, r0 = ((item >> 3) & 15) * 4, w0 = (item & 7) * 8;
    const bf16_t* U = (const bf16_t*)(p.ws + WS_U);
    bf16_t* OCAT = (bf16_t*)(p.ws + WS_ACT);
    LAS float* red = (LAS float*)lds;
    const int cg = tid & 127, ch = cg * 8, tg = tid >> 7;
    const bool rowconv = cg < 64;
    float bias[8], lg[8], lb[8];
    { const f32x4 b0 = *(const f32x4*)(p.conv_b + ch), b1 = *(const f32x4*)(p.conv_b + ch + 4);
      const f32x4 g0 = *(const f32x4*)(p.conv_ln_g + ch), g1 = *(const f32x4*)(p.conv_ln_g + ch + 4);
      const f32x4 l0 = *(const f32x4*)(p.conv_ln_b + ch), l1 = *(const f32x4*)(p.conv_ln_b + ch + 4);
#pragma unroll
      for (int i = 0; i < 4; ++i) { bias[i] = b0[i]; bias[4 + i] = b1[i]; lg[i] = g0[i]; lg[4 + i] = g1[i]; lb[i] = l0[i]; lb[4 + i] = l1[i]; } }
    LAS float* cwl = (LAS float*)(lds + 512);
    {
        f32x4 cwv[16];
#pragma unroll
        for (int q = 0; q < 16; ++q) { const int i = tid + 512 * q; const int ic = i < 31 * 256 ? i : 0; cwv[q] = *(const f32x4*)(p.conv_w + ic * 4); if (i >= 31 * 256) cwv[q] = (f32x4){0.f, 0.f, 0.f, 0.f}; }
#pragma unroll
        for (int q = 0; q < 16; ++q) *(LAS f32x4*)(cwl + (tid + 512 * q) * 4) = cwv[q];
    }
    __syncthreads();
    float y[8][8];
#pragma unroll
    for (int tk = 0; tk < 8; ++tk)
#pragma unroll
        for (int i = 0; i < 8; ++i) y[tk][i] = bias[i];
    int ltok[8];
    if (rowconv) {
        conv_window<8>(U + (size_t)(b * 4096 + (r0 + tg) * 64) * 1024 + ch, 1024, w0 - 15, cwl + ch, &y[0]);
#pragma unroll
        for (int tk = 0; tk < 8; ++tk) ltok[tk] = tg * 8 + tk;
    } else {
        conv_window<4>(U + (size_t)(b * 4096 + w0 + 2 * tg) * 1024 + ch, 64 * 1024, r0 - 15, cwl + ch, &y[0]);
        conv_window<4>(U + (size_t)(b * 4096 + w0 + 2 * tg + 1) * 1024 + ch, 64 * 1024, r0 - 15, cwl + ch, &y[4]);
#pragma unroll
        for (int tk = 0; tk < 8; ++tk) ltok[tk] = (tk & 3) * 8 + 2 * tg + (tk >> 2);
    }
    const int half = rowconv ? 0 : 1;
#pragma unroll
    for (int tk = 0; tk < 8; ++tk) {
        float s1 = 0.f, s2 = 0.f;
#pragma unroll
        for (int i = 0; i < 8; ++i) { s1 += y[tk][i]; s2 += y[tk][i] * y[tk][i]; }
        s1 = wave_sum(s1); s2 = wave_sum(s2);
        if ((tid & 63) == 0) { red[(ltok[tk] * 2 + half) * 2] = s1; red[(ltok[tk] * 2 + half) * 2 + 1] = s2; }
    }
    __syncthreads();
#pragma unroll
    for (int tk = 0; tk < 8; ++tk) {
        const int lt = ltok[tk];
        const float mean = (red[lt * 4] + red[lt * 4 + 2]) * (1.f / 1024.f);
        const float var = (red[lt * 4 + 1] + red[lt * 4 + 3]) * (1.f / 1024.f) - mean * mean;
        const float rstd = rsqrtf(fmaxf(var, 0.f) + 1e-5f);
        float o[8];
#pragma unroll
        for (int i = 0; i < 8; ++i) { const float yn = (y[tk][i] - mean) * rstd * lg[i] + lb[i]; o[i] = silu_f(yn); }
        u32x4 pk; pk[0] = cvt_pk_bf16(o[0], o[1]); pk[1] = cvt_pk_bf16(o[2], o[3]); pk[2] = cvt_pk_bf16(o[4], o[5]); pk[3] = cvt_pk_bf16(o[6], o[7]);
        const int tok = b * 4096 + (r0 + (lt >> 3)) * 64 + w0 + (lt & 7);
        if (DBG_ZERO_CONV) { pk[0] = 0; pk[1] = 0; pk[2] = 0; pk[3] = 0; }
        *(u32x4*)(OCAT + (size_t)tok * D + 1024 + ch) = pk;
    }
    (void)wid;
}

__device__ __forceinline__ void phase_gla_a_conv(const Params& p, LAS unsigned char* lds) {
    const int nItems = 256 + 512 + 64;
    for (int it = blockIdx.x; it < nItems; it += gridDim.x) {
        if (it < 256) conv_item(p, lds, it);
        else if (it < 768) gla_a_item(p, lds, it - 256, 0);
        else { const int hh = it - 768; gla_a_item(p, lds, 512 + (hh >> 1), 1 + (hh & 1)); }
        __syncthreads();
    }
}

template <int DIR>
__device__ __forceinline__ void scan_one(bf16_t* base, const float* db) {
    f32x4 S = {0.f, 0.f, 0.f, 0.f};
    {
        u32x2 kv[4]; f32x4 dc[4];
#pragma unroll
        for (int q = 0; q < 4; ++q) { const int slot = DIR == 0 ? q : 3 - q; kv[q] = *(const u32x2*)(base + (size_t)slot * 32768); dc[q] = *(const f32x4*)(db + slot * 128); }
#pragma unroll
        for (int q = 0; q < 4; ++q) { S[0] = dc[q][0] * S[0] + bf_lo(kv[q][0]); S[1] = dc[q][1] * S[1] + bf_hi(kv[q][0]); S[2] = dc[q][2] * S[2] + bf_lo(kv[q][1]); S[3] = dc[q][3] * S[3] + bf_hi(kv[q][1]); }
    }
#pragma unroll 1
    for (int b0 = 0; b0 < 64; b0 += 16) {
        u32x2 kv[16]; f32x4 dc[16];
#pragma unroll
        for (int q = 0; q < 16; ++q) { const int slot = DIR == 0 ? 4 + b0 + q : 67 - b0 - q; kv[q] = *(const u32x2*)(base + (size_t)slot * 32768); dc[q] = *(const f32x4*)(db + slot * 128); }
#pragma unroll
        for (int q = 0; q < 16; ++q) {
            const int slot = DIR == 0 ? 4 + b0 + q : 67 - b0 - q;
            u32x2 pk; pk[0] = cvt_pk_bf16(S[0], S[1]); pk[1] = cvt_pk_bf16(S[2], S[3]);
            *(u32x2*)(base + (size_t)slot * 32768) = pk;
            S[0] = dc[q][0] * S[0] + bf_lo(kv[q][0]); S[1] = dc[q][1] * S[1] + bf_hi(kv[q][0]); S[2] = dc[q][2] * S[2] + bf_lo(kv[q][1]); S[3] = dc[q][3] * S[3] + bf_hi(kv[q][1]);
        }
    }
}
__device__ __forceinline__ void phase_scan(const Params& p) {
    bf16_t* KVT = (bf16_t*)(p.ws + WS_HID);
    const float* DEC = (const float*)(p.ws + WS_DEC);
    for (int gid = blockIdx.x * 512 + otid(); gid < 2 * 8 * 256 * 32; gid += gridDim.x * 512) {
        const int d = gid >> 16, bh = (gid >> 13) & 7, e = (gid >> 5) & 255, jg = gid & 31;
        bf16_t* base = KVT + (size_t)(d * 8 + bh) * NSLOT * 32768 + e * 128 + jg * 4;
        const float* db = DEC + (size_t)(d * 8 + bh) * NSLOT * 128 + jg * 4;
        if (d == 0) scan_one<0>(base, db); else scan_one<1>(base, db);
    }
}

__device__ __forceinline__ void gla_c_item(const Params& p, LAS unsigned char* lds, int item) {
    const int tid = otid(), wid = tid >> 6, lane = tid & 63, fr = lane & 15, fq = lane >> 4;
    const int bh = item >> 6, n = item & 63, b = bh >> 2, h = bh & 3, slot = 4 + n;
    const int row0 = b * 4096 + n * 64;
    const bf16_t* PX = (const bf16_t*)(p.ws + WS_PX);
    const bf16_t* KVT = (const bf16_t*)(p.ws + WS_HID);
    bf16_t* OCAT = (bf16_t*)(p.ws + WS_ACT);
    LAS float* bc = (LAS float*)(lds + L_BC);
    const float* bcg = (const float*)(p.ws + WS_BC) + ((size_t)bh * 64 + n) * 64 * 128;
    f32x4 bcv[2][4];
#pragma unroll
    for (int d = 0; d < 2; ++d)
#pragma unroll
        for (int it = 0; it < 4; ++it) bcv[d][it] = *(const f32x4*)(bcg + (size_t)d * 8 * 64 * 64 * 128 + (size_t)(tid + 512 * it) * 4);
    const bf16_t* vtg = (const bf16_t*)(p.ws + WS_VT) + ((size_t)bh * 64 + n) * 256 * 64;
    bf16x8 vfr[2][2];
#pragma unroll
    for (int ks = 0; ks < 2; ++ks)
#pragma unroll
        for (int et = 0; et < 2; ++et) vfr[ks][et] = *(const bf16x8*)(vtg + (32 * wid + 16 * et + fr) * 64 + ks * 32 + fq * 8);
    f32x4 o[2][4];
#pragma unroll
    for (int et = 0; et < 2; ++et)
#pragma unroll
        for (int tt = 0; tt < 4; ++tt) o[et][tt] = (f32x4){0.f, 0.f, 0.f, 0.f};
    for (int d = 0; d < 2; ++d) {
#pragma unroll
        for (int it = 0; it < 4; ++it) {
            const int id = tid + 512 * it, t = id >> 5, j4 = (id & 31) * 4;
            const f32x4 v = d == 0 ? bcv[0][it] : bcv[1][it];
            bc[t * 129 + j4] = v[0]; bc[t * 129 + j4 + 1] = v[1]; bc[t * 129 + j4 + 2] = v[2]; bc[t * 129 + j4 + 3] = v[3];
        }
        __syncthreads();
        const int tm = d == 0 ? 31 : 32;
        { const int t = tid & 63;
#pragma unroll
          for (int it = 0; it < 2; ++it) {
              const int jg = (tid >> 6) + 8 * it;
              const u32x4 qv = *(const u32x4*)(PX + (size_t)(row0 + t) * PXW + 1536 + h * 128 + jg * 8);
              const u32x4 kv = *(const u32x4*)(PX + (size_t)(row0 + t) * PXW + h * 128 + jg * 8);
              float qs[8], ks[8], qe[8];
#pragma unroll
              for (int i = 0; i < 8; ++i) {
                  const int j = jg * 8 + i;
                  const float qf = ((i & 1) ? bf_hi(qv[i >> 1]) : bf_lo(qv[i >> 1])) * 0.08838834764831845f;
                  const float kf = (i & 1) ? bf_hi(kv[i >> 1]) : bf_lo(kv[i >> 1]);
                  const float bb = bc[t * 129 + j], bm = bc[tm * 129 + j];
                  qs[i] = qf * __expf(bb - bm); ks[i] = kf * __expf(bm - bb); qe[i] = qf * __expf(bb);
              }
              u32x4 a, c, e;
#pragma unroll
              for (int i = 0; i < 4; ++i) { a[i] = cvt_pk_bf16(qs[2 * i], qs[2 * i + 1]); c[i] = cvt_pk_bf16(ks[2 * i], ks[2 * i + 1]); e[i] = cvt_pk_bf16(qe[2 * i], qe[2 * i + 1]); }
              *(LAS u32x4*)(lds + L_QS + t * 272 + jg * 16) = a;
              *(LAS u32x4*)(lds + L_KS + t * 272 + jg * 16) = c;
              *(LAS u32x4*)(lds + L_QE + t * 272 + jg * 16) = e;
          } }
        __syncthreads();
        { const int tt = wid & 3;
#pragma unroll
          for (int sh = 0; sh < 2; ++sh) {
              const int st = (wid >> 2) * 2 + sh;
              f32x4 a = {0.f, 0.f, 0.f, 0.f};
#pragma unroll
              for (int ks = 0; ks < 4; ++ks) {
                  const bf16x8 av = *(const LAS bf16x8*)(lds + L_KS + (16 * st + fr) * 272 + (ks * 32 + fq * 8) * 2);
                  const bf16x8 bv = *(const LAS bf16x8*)(lds + L_QS + (16 * tt + fr) * 272 + (ks * 32 + fq * 8) * 2);
                  a = __builtin_amdgcn_mfma_f32_16x16x32_bf16(av, bv, a, 0, 0, 0);
              }
              const int t = 16 * tt + fr, s0 = 16 * st + 4 * fq;
              float m[4];
#pragma unroll
              for (int i = 0; i < 4; ++i) { const int s = s0 + i; const bool keep = d == 0 ? (s <= t) : (s >= t); m[i] = keep ? a[i] : 0.f; }
              u32x2 pk; pk[0] = cvt_pk_bf16(m[0], m[1]); pk[1] = cvt_pk_bf16(m[2], m[3]);
              *(LAS u32x2*)(lds + L_ATT + t * 144 + s0 * 2) = pk;
          } }
        __syncthreads();
#pragma unroll
        for (int ks = 0; ks < 2; ++ks) {
#pragma unroll
            for (int tt = 0; tt < 4; ++tt) {
                const bf16x8 bv = *(const LAS bf16x8*)(lds + L_ATT + (16 * tt + fr) * 144 + (ks * 32 + fq * 8) * 2);
#pragma unroll
                for (int et = 0; et < 2; ++et) o[et][tt] = __builtin_amdgcn_mfma_f32_16x16x32_bf16(vfr[ks][et], bv, o[et][tt], 0, 0, 0);
            }
        }
        const bf16_t* sb = KVT + ((size_t)(d * 8 + bh) * NSLOT + slot) * 32768;
#pragma unroll
        for (int ks = 0; ks < 4; ++ks) {
            bf16x8 av[2];
#pragma unroll
            for (int et = 0; et < 2; ++et) av[et] = *(const bf16x8*)(sb + (32 * wid + 16 * et + fr) * 128 + ks * 32 + fq * 8);
#pragma unroll
            for (int tt = 0; tt < 4; ++tt) {
                const bf16x8 bv = *(const LAS bf16x8*)(lds + L_QE + (16 * tt + fr) * 272 + (ks * 32 + fq * 8) * 2);
#pragma unroll
                for (int et = 0; et < 2; ++et) o[et][tt] = __builtin_amdgcn_mfma_f32_16x16x32_bf16(av[et], bv, o[et][tt], 0, 0, 0);
            }
        }
        __syncthreads();
    }
    LAS float* red = (LAS float*)(lds + L_RED);
#pragma unroll
    for (int tt = 0; tt < 4; ++tt) {
        float s = 0.f;
#pragma unroll
        for (int et = 0; et < 2; ++et)
#pragma unroll
            for (int i = 0; i < 4; ++i) s += o[et][tt][i] * o[et][tt][i];
        s += __shfl_xor(s, 16, 64); s += __shfl_xor(s, 32, 64);
        if (fq == 0) red[wid * 64 + 16 * tt + fr] = s;
    }
    __syncthreads();
#pragma unroll
    for (int tt = 0; tt < 4; ++tt) {
        const int t = 16 * tt + fr;
        float tot = 0.f;
#pragma unroll
        for (int w = 0; w < 8; ++w) tot += red[w * 64 + t];
        const float rs = rsqrtf(tot * (1.f / 256.f) + 1e-5f);
#pragma unroll
        for (int et = 0; et < 2; ++et) {
            const int e = 32 * wid + 16 * et + 4 * fq;
            const f32x4 gn = *(const f32x4*)(p.gla_norm + e);
            const u32x2 gv = *(const u32x2*)(PX + (size_t)(row0 + t) * PXW + 2048 + h * 256 + e);
            const float g0 = bf_lo(gv[0]), g1 = bf_hi(gv[0]), g2 = bf_lo(gv[1]), g3 = bf_hi(gv[1]);
            const float v0 = o[et][tt][0] * rs * gn[0] * silu_f(g0), v1 = o[et][tt][1] * rs * gn[1] * silu_f(g1);
            const float v2 = o[et][tt][2] * rs * gn[2] * silu_f(g2), v3 = o[et][tt][3] * rs * gn[3] * silu_f(g3);
            u32x2 pk; pk[0] = cvt_pk_bf16(v0, v1); pk[1] = cvt_pk_bf16(v2, v3);
            if (DBG_ZERO_GLA) { pk[0] = 0; pk[1] = 0; }
            *(u32x2*)(OCAT + (size_t)(row0 + t) * D + h * 256 + e) = pk;
        }
    }
}
__device__ __forceinline__ void phase_gla_c(const Params& p, LAS unsigned char* lds) {
    for (int it = blockIdx.x; it < 512; it += gridDim.x) { gla_c_item(p, lds, it); __syncthreads(); }
}

__device__ __forceinline__ void run_gemm_gate(const Params& p, LAS unsigned char* lds, bool first) {
    unsigned char* ws = p.ws;
    Gemm g; g.A = (const bf16_t*)(ws + WS_ACT); g.Bt = (const bf16_t*)(ws + (first ? WS_WT1 : WS_WT5)); g.M = first ? MT : TL; g.N = NFF; g.K = D;
    Order S; S.init(g.M / BM, NFF / BM, gridDim.x, blockIdx.x, 0, D / BK);
    EpiGate E; E.H = (bf16_t*)(ws + WS_HID);
    gemm_phase(lds, g, S, E);
}
template <int WHICH>
__device__ __forceinline__ void run_gemm_resid(const Params& p, LAS unsigned char* lds) {
    constexpr int which = WHICH;
    unsigned char* ws = p.ws;
    float* H1 = (float*)(ws + WS_H1);
    Gemm g; EpiResid<(WHICH == 2 ? 2 : 1)> E; E.mod = (const float*)(ws + WS_MOD); E.out = H1; E.part = (float*)(ws + WS_PART);
    E.st.xbuf = (unsigned*)(ws + WS_XB); E.st.cnt = (unsigned*)(ws + WS_CNT) + which * 32 * 64; E.gain = which == 2 ? p.norm_final : (which == 1 ? p.norm_ffn2 : p.norm_mix); E.sh_idx = which == 0 ? 3 : 6; E.sc_idx = which == 0 ? 4 : 7; E.act = (bf16_t*)(ws + WS_ACT); E.fout = p.out;
    if (which == 0) { g.A = (const bf16_t*)(ws + WS_HID); g.Bt = (const bf16_t*)(ws + WS_WT2); g.M = TL; g.K = DFF; E.resid_lat = p.x; E.resid_ctx = p.ctx; E.gidx = 2; E.gs = 0.5f; }
    else if (which == 1) { g.A = (const bf16_t*)(ws + WS_ACT); g.Bt = (const bf16_t*)(ws + WS_WT4); g.M = TL; g.K = D; E.resid_lat = H1; E.resid_ctx = H1; E.gidx = 5; E.gs = 1.0f; }
    else { g.A = (const bf16_t*)(ws + WS_HID); g.Bt = (const bf16_t*)(ws + WS_WT6); g.M = TL; g.K = DFF; E.resid_lat = H1; E.resid_ctx = H1; E.gidx = 8; E.gs = 0.5f; }
    g.N = D;
    Order S; S.init(g.M / BM, D / BM, gridDim.x, blockIdx.x, which == 0 ? 2 : 0, g.K / BK);
    gemm_phase(lds, g, S, E);
}
__device__ __forceinline__ void run_gemm_in(const Params& p, LAS unsigned char* lds) {
    unsigned char* ws = p.ws;
    Gemm g; g.A = (const bf16_t*)(ws + WS_ACT); g.Bt = (const bf16_t*)(ws + WS_WT3); g.M = TL; g.N = N3; g.K = D;
    Order S; S.init(TL / BM, N3 / BM, gridDim.x, blockIdx.x, 1, D / BK);
    EpiIn E; E.PX = (bf16_t*)(ws + WS_PX); E.U = (bf16_t*)(ws + WS_U); E.GK = (float*)(ws + WS_GK);
    gemm_phase(lds, g, S, E);
}


#define XB_TMO      128
#define XB_XCNT(j)  (256  + 64 * (j))
#define XB_XSUB(j)  (1280 + 64 * (j))
#define XB_XGEN(j)  (2304 + 64 * (j))
#define XB_TOP      3328
#define XB_TOPGEN   3392
#define XCD_BAR_WORDS 3456
#define XB_SPIN_CAP (1u << 18)
__device__ __forceinline__ unsigned xb_ld(unsigned* p)              { return __hip_atomic_load(p, __ATOMIC_RELAXED, __HIP_MEMORY_SCOPE_AGENT); }
__device__ __forceinline__ unsigned xb_add(unsigned* p, unsigned v) { return __hip_atomic_fetch_add(p, v, __ATOMIC_RELAXED, __HIP_MEMORY_SCOPE_AGENT); }
__device__ __forceinline__ unsigned xb_xcc_id() { return (unsigned)__builtin_amdgcn_s_getreg((3 << 11) | 20) & 0xFu; }
#define XB_SPIN(cond, bar) do { unsigned _sp = 0; while (cond) { __builtin_amdgcn_s_sleep(1); \
    if ((++_sp & 255u) == 0u) { if (xb_ld(&(bar)[XB_TMO])) break; if (_sp > XB_SPIN_CAP) { atomicAdd(&(bar)[XB_TMO], 1u); break; } } } } while (0)
struct XcdBarrier { unsigned* bar; unsigned x; volatile LAS unsigned* st; };
__device__ __forceinline__ XcdBarrier xcd_barrier_post(unsigned* bar, volatile LAS unsigned* st) {
    XcdBarrier b; b.bar = bar; b.x = xb_xcc_id(); b.st = st;
    if (threadIdx.x == 0) (void)xb_add(&bar[XB_XCNT(b.x)], 1u);
    return b;
}
__device__ __forceinline__ void xcd_barrier_complete(unsigned* bar, unsigned x, unsigned& nloc, unsigned& nx) {
    const unsigned G = gridDim.x * gridDim.y * gridDim.z;
    unsigned sum, cnt, mine, sp = 0u;
    for (;;) {
        sum = 0u; cnt = 0u; mine = 0u;
#pragma unroll
        for (unsigned j = 0; j < 16; ++j) { const unsigned c = xb_ld(&bar[XB_XCNT(j)]); sum += c; cnt += (c > 0u) ? 1u : 0u; mine = (j == x) ? c : mine; }
        if (sum == G) break;
        __builtin_amdgcn_s_sleep(1);
        if ((++sp & 255u) == 0u) { if (xb_ld(&bar[XB_TMO])) break; if (sp > XB_SPIN_CAP) { atomicAdd(&bar[XB_TMO], 1u); break; } }
    }
    nloc = mine > 0u ? mine : 1u; nx = cnt > 0u ? cnt : 1u;
}
__device__ __forceinline__ void xcd_barrier(const XcdBarrier& b) {
    asm volatile("s_waitcnt vmcnt(0)" ::: "memory");
    __syncthreads();
    if (threadIdx.x == 0) {
        unsigned* bar = b.bar;
        __builtin_amdgcn_s_waitcnt(0);
        unsigned nloc = b.st[0], nx = b.st[1];
        if (nloc == 0u) { xcd_barrier_complete(bar, b.x, nloc, nx); b.st[0] = nloc; b.st[1] = nx; }
        const unsigned old = xb_add(&bar[XB_XSUB(b.x)], 1u);
        const unsigned gen = old / nloc;
        if (old + 1u == (gen + 1u) * nloc) {
            __builtin_amdgcn_fence(__ATOMIC_RELEASE, "agent");
            asm volatile("s_waitcnt vmcnt(0)" ::: "memory");
            const unsigned og = xb_add(&bar[XB_TOP], 1u);
            const unsigned tg = og / nx;
            if (og + 1u == (tg + 1u) * nx) xb_add(&bar[XB_TOPGEN], 1u);
            else XB_SPIN(xb_ld(&bar[XB_TOPGEN]) == tg, bar);
            __builtin_amdgcn_fence(__ATOMIC_ACQUIRE, "agent");
            xb_add(&bar[XB_XGEN(b.x)], 1u);
            asm volatile("s_waitcnt vmcnt(0)" ::: "memory");
        } else {
            XB_SPIN(xb_ld(&bar[XB_XGEN(b.x)]) == gen, bar);
            __builtin_amdgcn_fence(__ATOMIC_ACQUIRE, "agent");
            asm volatile("s_waitcnt vmcnt(0)" ::: "memory");
        }
    }
    __syncthreads();
}

__device__ __forceinline__ void grid_barrier(cg::grid_group& grid) {
    asm volatile("s_waitcnt vmcnt(0)" ::: "memory");
    __syncthreads();
    grid.sync();
    __builtin_amdgcn_fence(__ATOMIC_ACQUIRE, "agent");
    asm volatile("s_waitcnt vmcnt(0)" ::: "memory");
    __syncthreads();
}
#ifndef DBG_AFTER
#define DBG_AFTER -1
#endif
#ifndef DBG_OFF
#define DBG_OFF WS_HID
#endif
#ifndef DBG_F32
#define DBG_F32 0
#endif
__device__ __forceinline__ void dbg_dump(const Params& p) {
    const size_t n = (size_t)TL * D;
    for (size_t i = (size_t)blockIdx.x * 512 + threadIdx.x; i < n; i += (size_t)gridDim.x * 512) {
        float v;
        if (DBG_F32) v = ((const float*)(p.ws + DBG_OFF))[i]; else v = bf_lo(((const bf16_t*)(p.ws + DBG_OFF))[i]);
        if (!(fabsf(v) < 1e30f)) v = 777.f;
        p.out[i] = v;
    }
}
#define PHASE(n, body) do { if (ph_lo <= (n) && (n) < ph_hi) { if constexpr (((REP_MASK) >> (n)) & 1) { body; xcd_barrier(xb); } if constexpr (PH_ON(n)) { body; } if ((n) + 1 < ph_hi && (n) != 12) { if ((n) == 0) grid_barrier(grid); else xcd_barrier(xb); } if ((n) == DBG_AFTER) { dbg_dump(p); return; } } } while (0)
__global__ void __launch_bounds__(512, 2) mega(Params p, int ph_lo, int ph_hi) {
    extern __shared__ __attribute__((aligned(16))) unsigned char shm[];
    LAS unsigned char* lds = (LAS unsigned char*)shm;
    cg::grid_group grid = cg::this_grid();
    volatile LAS unsigned* xst = (volatile LAS unsigned*)(lds + LDS_BYTES - 16);
    if (threadIdx.x == 0) { xst[0] = 0u; xst[1] = 0u; }
    __syncthreads();
    if (blockIdx.x == 0) { unsigned* zw = (unsigned*)(p.ws + WS_BAR); for (int i = threadIdx.x; i < (int)(WS_ZERO_BYTES / 4); i += 512) zw[i] = 0u; }
    XcdBarrier xb; xb.bar = (unsigned*)(p.ws + WS_BAR); xb.x = xb_xcc_id(); xb.st = xst;
    PHASE(0, phase_prep_weights(p, lds));
    if (threadIdx.x == 0) (void)xb_add(&xb.bar[XB_XCNT(xb.x)], 1u);
    PHASE(1, phase_modnorm<0>(p, 0, MT, p.norm_ffn1, 0, 1));
    PHASE(2, (run_gemm_gate(p, lds, true), wconv_tail(p, lds, 34 * 44, 1408, 2112)));
    PHASE(3, run_gemm_resid<0>(p, lds));
    PHASE(4, phase_ctxnorm(p, lds));
    PHASE(5, (run_gemm_in(p, lds), wconv_tail(p, lds, 686, 2784, 4448)));
    PHASE(6, phase_gla_a_conv(p, lds));
    PHASE(7, phase_scan(p));
    PHASE(8, phase_gla_c(p, lds));
    PHASE(9, run_gemm_resid<1>(p, lds));
    PHASE(11, (run_gemm_gate(p, lds, false), wconv_tail(p, lds, 32 * 44, 4448, 5152), ((blockIdx.x >= 128 && blockIdx.x < 144) ? (gemv_item(p, lds, (int)blockIdx.x), __syncthreads()) : (void)0)));
    PHASE(12, run_gemm_resid<2>(p, lds));
}

extern "C" void kernel_launch(void* const* d_in, const int* in_sizes, int n_in, void* d_out, int out_size, void* d_ws, size_t ws_size, hipStream_t stream) {
    static int grid_blocks = 0;
    if (grid_blocks == 0) {
        if (ws_size < WS_END) { fprintf(stderr, "kernel_launch: workspace too small: %zu < %zu\n", ws_size, (size_t)WS_END); grid_blocks = -1; return; }
        int dev = 0, cus = 0, per_cu = 0;
        hipGetDevice(&dev);
        hipDeviceGetAttribute(&cus, hipDeviceAttributeMultiprocessorCount, dev);
        if (hipFuncSetAttribute((const void*)mega, hipFuncAttributeMaxDynamicSharedMemorySize, LDS_BYTES) != hipSuccess) { fprintf(stderr, "kernel_launch: hipFuncSetAttribute failed\n"); }
        if (hipOccupancyMaxActiveBlocksPerMultiprocessor(&per_cu, (const void*)mega, 512, LDS_BYTES) != hipSuccess || per_cu < 1) { fprintf(stderr, "kernel_launch: occupancy query gave %d\n", per_cu); per_cu = 1; }
        (void)hipGetLastError();
        if (per_cu > 1) per_cu = 1;
        grid_blocks = cus * per_cu;
        if (grid_blocks != 256) { fprintf(stderr, "kernel_launch: built for 256 workgroups (256 CUs x 1); got %d: nothing launched\n", grid_blocks); grid_blocks = -1; return; }
        fprintf(stderr, "kernel_launch: grid %d blocks (cus %d)\n", grid_blocks, cus);
    }
    if (grid_blocks < 0) return;
    Params p{};
    const float* const* in = (const float* const*)d_in;
    p.x = in[0]; p.c = in[1]; p.ctx = in[2]; p.c_ctx = in[3]; p.w_mod = in[4]; p.b_mod = in[5]; p.norm_ffn1 = in[6]; p.w_ffn1_in = in[7]; p.w_ffn1_out = in[8];
    p.norm_mix = in[9]; p.w_in = in[10]; p.w_gk2 = in[11]; p.b_gk2 = in[12]; p.gla_norm = in[13]; p.conv_w = in[14]; p.conv_b = in[15]; p.conv_ln_g = in[16];
    p.conv_ln_b = in[17]; p.w_out = in[18]; p.norm_ffn2 = in[19]; p.w_ffn2_in = in[20]; p.w_ffn2_out = in[21]; p.norm_final = in[22];
    p.out = (float*)d_out; p.ws = (unsigned char*)d_ws;
    int ph_lo = 0, ph_hi = NPHASE;
    void* args[] = {&p, &ph_lo, &ph_hi};
    hipError_t e = hipLaunchCooperativeKernel((const void*)mega, dim3(grid_blocks), dim3(512), args, LDS_BYTES, stream);
    if (e != hipSuccess) fprintf(stderr, "kernel_launch: cooperative launch failed: %s (grid %d)\n", hipGetErrorString(e), grid_blocks);
}
```

```cpp
#include <hip/hip_runtime.h>
#include <hip/hip_cooperative_groups.h>
#include <cstdio>
namespace cg = cooperative_groups;

#define LAS __attribute__((address_space(3)))
typedef unsigned short bf16_t;
typedef short bf16x8 __attribute__((ext_vector_type(8)));
typedef float f32x4 __attribute__((ext_vector_type(4)));
typedef float f32x2 __attribute__((ext_vector_type(2)));
typedef unsigned u32x4 __attribute__((ext_vector_type(4)));
typedef unsigned u32x2 __attribute__((ext_vector_type(2)));

constexpr int D = 2048, TL = 8192, TCX = 512, MT = 8704, DFF = 5632, NFF = 11264, NIN = 5152, N3 = 5376, PXW = 3072, NMOD = 18432;
constexpr int NSLOT = 68;
constexpr int LDS_BYTES = 147456;
constexpr int NPHASE = 14;
#ifndef PH_MASK
#define PH_MASK 0x3fff
#endif
#define PH_ON(n) (((PH_MASK) >> (n)) & 1)
#ifndef REP_MASK
#define REP_MASK 0
#endif
#ifndef DBG_ZERO_GLA
#define DBG_ZERO_GLA 0
#endif
#ifndef DBG_ZERO_CONV
#define DBG_ZERO_CONV 0
#endif

constexpr size_t al256(size_t x) { return (x + 255) & ~(size_t)255; }
constexpr size_t WS_WT1 = 0;
constexpr size_t WS_WT2 = WS_WT1 + al256((size_t)NFF * D * 2);
constexpr size_t WS_WT3 = WS_WT2 + al256((size_t)D * DFF * 2);
constexpr size_t WS_WT4 = WS_WT3 + al256((size_t)N3 * D * 2);
constexpr size_t WS_WT5 = WS_WT4 + al256((size_t)D * D * 2);
constexpr size_t WS_WT6 = WS_WT5 + al256((size_t)NFF * D * 2);
constexpr size_t WS_MOD = WS_WT6 + al256((size_t)D * DFF * 2);
constexpr size_t WS_ACT = WS_MOD + al256((size_t)3 * NMOD * 4);
constexpr size_t WS_HID = WS_ACT + al256((size_t)MT * D * 2);
constexpr size_t WS_H1 = WS_HID + al256((size_t)MT * DFF * 2);
constexpr size_t WS_PX = WS_H1 + al256((size_t)MT * D * 4);
constexpr size_t WS_U = WS_PX + al256((size_t)MT * PXW * 2);
constexpr size_t WS_GK = WS_U + al256((size_t)TL * 1024 * 2);
constexpr size_t WS_DEC = WS_GK + al256((size_t)MT * 32 * 4);
constexpr size_t WS_PART = WS_DEC + al256((size_t)2 * 8 * NSLOT * 128 * 4);
constexpr size_t WS_BAR = WS_PART + al256((size_t)11 * TCX * D * 4);
constexpr size_t WS_CNT = WS_BAR + 16384;
constexpr size_t WS_XB = WS_CNT + 3 * 32 * 256;
constexpr size_t WS_BC = WS_XB + al256((size_t)TL * 8 * 4);
constexpr size_t WS_VT = WS_BC + (size_t)2 * 8 * 64 * 64 * 128 * 4;
constexpr size_t WS_END = WS_VT + (size_t)8 * 64 * 256 * 64 * 2;
constexpr size_t WS_ZERO_BYTES = 16384 + 3 * 32 * 256;

struct Params {
    const float* x; const float* c; const float* ctx; const float* c_ctx; const float* w_mod; const float* b_mod;
    const float* norm_ffn1; const float* w_ffn1_in; const float* w_ffn1_out; const float* norm_mix; const float* w_in;
    const float* w_gk2; const float* b_gk2; const float* gla_norm; const float* conv_w; const float* conv_b;
    const float* conv_ln_g; const float* conv_ln_b; const float* w_out; const float* norm_ffn2; const float* w_ffn2_in;
    const float* w_ffn2_out; const float* norm_final;
    float* out; unsigned char* ws;
};

typedef __bf16 bf16x2_t __attribute__((ext_vector_type(2)));
__device__ __forceinline__ unsigned cvt_pk_bf16(float lo, float hi) { f32x2 f = {lo, hi}; bf16x2_t v = __builtin_convertvector(f, bf16x2_t); return __builtin_bit_cast(unsigned, v); }
__device__ __forceinline__ float bf_lo(unsigned u) { return __uint_as_float(u << 16); }
__device__ __forceinline__ float bf_hi(unsigned u) { return __uint_as_float(u & 0xffff0000u); }
__device__ __forceinline__ float wave_sum(float v) {
#pragma unroll
    for (int o = 32; o >= 1; o >>= 1) v += __shfl_xor(v, o, 64);
    return v;
}
__device__ __forceinline__ float silu_f(float x) { return x * __builtin_amdgcn_rcpf(1.f + __expf(-x)); }
__device__ __forceinline__ float sigmoid_f(float x) { return __builtin_amdgcn_rcpf(1.f + __expf(-x)); }
__device__ __forceinline__ int otid() { int t = threadIdx.x; asm volatile("" : "+v"(t)); return t; }
__host__ __device__ __forceinline__ int perm32(int rho) { const int n = rho >> 4, i = rho & 15; return 8 * (i >> 2) + 4 * n + (i & 3); }

constexpr int BM = 256, BK = 64, HALF = 128, HTB = HALF * BK * 2, NXCD = 8, WGM = 4;
__device__ __forceinline__ int lds_byte(int r, int c) { const int st = (r >> 4) * 2 + (c >> 5), rr = r & 15, cc = c & 31, ob = rr * 64 + cc * 2; return st * 1024 + (ob ^ (((ob >> 9) & 1) << 5)); }
__device__ __forceinline__ void stage_rc(int b, int& R, int& C) { const int st = b / 1024, sb = b % 1024, swz = sb ^ (((sb >> 9) & 1) << 5); R = (st >> 1) * 16 + swz / 64; C = (st & 1) * 32 + (swz % 64) / 2; }

struct Unit { int pm, pn, kt0, nt; };
struct Gemm { const bf16_t* A; const bf16_t* Bt; int M, N, K; };
struct Order {
    int nM, nN, nwg, G, c, extra, mode, ntk;
    __device__ void init(int nM_, int nN_, int G_, int c_, int mode_, int ntk_) { nM = nM_; nN = nN_; nwg = nM * nN; G = G_; c = c_; mode = mode_; ntk = ntk_; extra = mode == 1 ? 14 : 0; }
    __device__ bool next(int i, Unit& u) const {
        long L = (long)i * G + c;
        u.kt0 = 0; u.nt = ntk;
        if (mode == 2) {
            const bool has_small = c < 176;
            if (has_small && i == 0) { const int idx = c; u.pm = nM + idx / 88; const int rem = idx % 88; u.pn = rem / 11; u.kt0 = (rem % 11) * 8; u.nt = 8; return true; }
            if ((has_small ? i - 1 : i) != 0) return false;
            L = c;
        }
        if (L >= nwg + extra) return false;
        if (L >= nwg) {
            const int idx = (int)L - nwg;
            if (mode == 1) { u.pm = nM + idx / 7; const int q = idx % 7; u.pn = q < 6 ? q : 20; }
            else return false;
            return true;
        }
        int wgid = (int)L; { const int q = nwg / NXCD, r = nwg % NXCD, xcd = wgid % NXCD, off = wgid / NXCD; wgid = (xcd < r ? xcd * (q + 1) : r * (q + 1) + (xcd - r) * q) + off; }
        const int nig = WGM * nN, gid = wgid / nig, fm = gid * WGM, gsz = (nM - fm) < WGM ? (nM - fm) : WGM;
        u.pm = fm + ((wgid % nig) % gsz); u.pn = (wgid % nig) / gsz; return true;
    }
};


constexpr int L_RS_P = 131072, L_RS_S = 131072 + 4096;
struct RowStats {
    unsigned* xbuf; unsigned* cnt;
    __device__ __forceinline__ void run(const f32x4 (&v)[2][2][4][2], const Unit& u, int wr, int wc, int fr, int fq, LAS unsigned char* lds, int wid, int lane) const {
        LAS float* P = (LAS float*)(lds + L_RS_P);
        LAS float* S = (LAS float*)(lds + L_RS_S);
#pragma unroll
        for (int ai = 0; ai < 2; ++ai)
#pragma unroll
            for (int m = 0; m < 4; ++m) {
                float q = 0.f;
#pragma unroll
                for (int bj = 0; bj < 2; ++bj)
#pragma unroll
                    for (int n = 0; n < 2; ++n) { const f32x4 x = v[ai][bj][m][n]; q += (x[0] * x[0] + x[1] * x[1]) + (x[2] * x[2] + x[3] * x[3]); }
                q += __shfl_xor(q, 16, 64); q += __shfl_xor(q, 32, 64);
                if (fq == 0) P[(ai * HALF + wr * 64 + m * 16 + fr) * 4 + wc] = q;
            }
        __syncthreads();
        const int row = wid * 32 + (lane & 31);
        if (lane < 32) {
            const float tot = (P[row * 4 + 0] + P[row * 4 + 1]) + (P[row * 4 + 2] + P[row * 4 + 3]);
            __hip_atomic_store(xbuf + (size_t)(u.pm * BM + row) * 8 + u.pn, __float_as_uint(tot), __ATOMIC_RELAXED, __HIP_MEMORY_SCOPE_AGENT);
        }
        asm volatile("s_waitcnt vmcnt(0)" ::: "memory");
        if (lane == 0) __hip_atomic_fetch_add(cnt + 64 * u.pm, 1u, __ATOMIC_RELAXED, __HIP_MEMORY_SCOPE_AGENT);
        if (wid == 0) {
            unsigned spins = 0;
            while ((unsigned)__builtin_amdgcn_readfirstlane(__hip_atomic_load(cnt + 64 * u.pm, __ATOMIC_RELAXED, __HIP_MEMORY_SCOPE_AGENT)) < 64u) {
                __builtin_amdgcn_s_sleep(2);
                if (++spins > (1u << 22)) break;
            }
            __builtin_amdgcn_fence(__ATOMIC_ACQUIRE, "agent");
        }
        asm volatile("s_waitcnt vmcnt(0) lgkmcnt(0)" ::: "memory");
        __syncthreads();
        if (lane < 32) {
            const unsigned* slot = xbuf + (size_t)(u.pm * BM + row) * 8; float tot = 0.f;
#pragma unroll
            for (int t = 0; t < 8; ++t) tot += __uint_as_float(__hip_atomic_load(slot + t, __ATOMIC_RELAXED, __HIP_MEMORY_SCOPE_AGENT));
            S[row] = rsqrtf(tot * (1.f / 2048.f) + 1e-6f);
        }
        __syncthreads();
    }
};

struct EpiGate {
    bf16_t* H;
    __device__ __forceinline__ bool defer(const Unit&) const { return false; }
    __device__ __forceinline__ void fused(f32x4 (&)[2][2][4][2], const Unit&, int, int, int, int, LAS unsigned char*, int, int) const {}
    __device__ __forceinline__ void operator()(const f32x4 (&acc)[2][2][4][2], const Unit& u, int wr, int wc, int fr, int fq) const {
        const int row0 = u.pm * BM + wr * 64 + fr, col0 = u.pn * 128 + wc * 32 + 8 * fq;
#pragma unroll
        for (int ai = 0; ai < 2; ++ai)
#pragma unroll
            for (int m = 0; m < 4; ++m) {
                float o[8];
#pragma unroll
                for (int n = 0; n < 2; ++n)
#pragma unroll
                    for (int i = 0; i < 4; ++i) o[n * 4 + i] = silu_f(acc[ai][0][m][n][i]) * acc[ai][1][m][n][i];
                u32x4 pk; pk[0] = cvt_pk_bf16(o[0], o[1]); pk[1] = cvt_pk_bf16(o[2], o[3]); pk[2] = cvt_pk_bf16(o[4], o[5]); pk[3] = cvt_pk_bf16(o[6], o[7]);
                *(u32x4*)(H + (size_t)(row0 + ai * HALF + m * 16) * DFF + col0) = pk;
            }
    }
};
template <int FMODE> struct EpiResid {
    const float* resid_lat; const float* resid_ctx; float* out; const float* mod; int gidx; float gs; float* part;
    RowStats st; const float* gain; int sh_idx, sc_idx; bf16_t* act; float* fout;
    __device__ __forceinline__ bool defer(const Unit& u) const { return FMODE != 0 && u.pm < TL / BM; }
    __device__ __forceinline__ void fused(f32x4 (&acc)[2][2][4][2], const Unit& u, int wr, int wc, int fr, int fq, LAS unsigned char* lds, int wid, int lane) const {
        const int rowt = u.pm * BM; const int set = rowt < 4096 ? 0 : 1;
        const float* md = mod + (size_t)set * NMOD;
        const int row0 = rowt + wr * 64 + fr, col0 = u.pn * BM + wc * 32 + 4 * fq;
        {
            f32x4 gv[2][2];
#pragma unroll
            for (int bj = 0; bj < 2; ++bj)
#pragma unroll
                for (int n = 0; n < 2; ++n) gv[bj][n] = *(const f32x4*)(md + gidx * D + col0 + bj * HALF + n * 16) * gs;
#pragma unroll
            for (int ai = 0; ai < 2; ++ai)
#pragma unroll
                for (int m = 0; m < 4; ++m) {
                    const size_t ro = (size_t)(row0 + ai * HALF + m * 16) * D + col0;
#pragma unroll
                    for (int bj = 0; bj < 2; ++bj)
#pragma unroll
                        for (int n = 0; n < 2; ++n) acc[ai][bj][m][n] = *(const f32x4*)(resid_lat + ro + bj * HALF + n * 16) + gv[bj][n] * acc[ai][bj][m][n];
                    asm volatile("" : "+v"(acc[ai][0][m][0]), "+v"(acc[ai][0][m][1]), "+v"(acc[ai][1][m][0]), "+v"(acc[ai][1][m][1]));
                    if (m & 1) asm volatile("" ::: "memory");
                }
        }
        st.run(acc, u, wr, wc, fr, fq, lds, wid, lane);
        const LAS float* S = (const LAS float*)(lds + L_RS_S);
        f32x4 g2[2][2], sh[2][2];
#pragma unroll
        for (int bj = 0; bj < 2; ++bj)
#pragma unroll
            for (int n = 0; n < 2; ++n) {
                const int c = col0 + bj * HALF + n * 16;
                g2[bj][n] = *(const f32x4*)(gain + c);
                if (FMODE == 1) { g2[bj][n] *= (*(const f32x4*)(md + sc_idx * D + c) + 1.f); sh[bj][n] = *(const f32x4*)(md + sh_idx * D + c); }
                else sh[bj][n] = (f32x4){0.f, 0.f, 0.f, 0.f};
            }
#pragma unroll
        for (int ai = 0; ai < 2; ++ai)
#pragma unroll
            for (int m = 0; m < 4; ++m) {
                const int r = ai * HALF + wr * 64 + m * 16 + fr; const float rs = S[r];
                const size_t ro = (size_t)(rowt + r) * D + col0;
#pragma unroll
                for (int bj = 0; bj < 2; ++bj)
#pragma unroll
                    for (int n = 0; n < 2; ++n) {
                        const f32x4 h = acc[ai][bj][m][n];
                        const f32x4 o = h * rs * g2[bj][n] + sh[bj][n];
                        if (FMODE == 1) {
                            *(f32x4*)(out + ro + bj * HALF + n * 16) = h;
                            u32x2 pk; pk[0] = cvt_pk_bf16(o[0], o[1]); pk[1] = cvt_pk_bf16(o[2], o[3]);
                            *(u32x2*)(act + ro + bj * HALF + n * 16) = pk;
                        } else *(f32x4*)(fout + ro + bj * HALF + n * 16) = o;
                    }
                asm volatile("" ::: "memory");
            }
    }
    __device__ __forceinline__ void operator()(const f32x4 (&acc)[2][2][4][2], const Unit& u, int wr, int wc, int fr, int fq) const {
        if (u.pm >= TL / BM) {
            float* pb = part + (size_t)(u.kt0 >> 3) * TCX * D;
            const int row0 = u.pm * BM - TL + wr * 64 + fr, col0 = u.pn * BM + wc * 32 + 4 * fq;
#pragma unroll
            for (int ai = 0; ai < 2; ++ai)
#pragma unroll
                for (int m = 0; m < 4; ++m)
#pragma unroll
                    for (int bj = 0; bj < 2; ++bj)
#pragma unroll
                        for (int n = 0; n < 2; ++n) *(f32x4*)(pb + (size_t)(row0 + ai * HALF + m * 16) * D + col0 + bj * HALF + n * 16) = acc[ai][bj][m][n];
            return;
        }
        const int rowt = u.pm * BM; const int set = rowt < 4096 ? 0 : (rowt < 8192 ? 1 : 2);
        const float* rb = rowt < TL ? resid_lat : (resid_ctx - (size_t)TL * D);
        const float* mg = mod + (size_t)set * NMOD + gidx * D;
        const int row0 = rowt + wr * 64 + fr, col0 = u.pn * BM + wc * 32 + 4 * fq;
        f32x4 gv[2][2];
#pragma unroll
        for (int bj = 0; bj < 2; ++bj)
#pragma unroll
            for (int n = 0; n < 2; ++n) gv[bj][n] = *(const f32x4*)(mg + col0 + bj * HALF + n * 16) * gs;
#pragma unroll
        for (int ai = 0; ai < 2; ++ai)
#pragma unroll
            for (int m = 0; m < 4; ++m) {
                const size_t ro = (size_t)(row0 + ai * HALF + m * 16) * D + col0;
#pragma unroll
                for (int bj = 0; bj < 2; ++bj)
#pragma unroll
                    for (int n = 0; n < 2; ++n) {
                        const f32x4 r = *(const f32x4*)(rb + ro + bj * HALF + n * 16);
                        *(f32x4*)(out + ro + bj * HALF + n * 16) = r + gv[bj][n] * acc[ai][bj][m][n];
                    }
            }
    }
};
struct EpiIn {
    bf16_t* PX; bf16_t* U; float* GK;
    __device__ __forceinline__ bool defer(const Unit&) const { return false; }
    __device__ __forceinline__ void fused(f32x4 (&)[2][2][4][2], const Unit&, int, int, int, int, LAS unsigned char*, int, int) const {}
    __device__ __forceinline__ void operator()(const f32x4 (&acc)[2][2][4][2], const Unit& u, int wr, int wc, int fr, int fq) const {
        const int row0 = u.pm * BM + wr * 64 + fr;
        if (u.pn < 12) {
            const int col0 = u.pn * BM + wc * 32 + 8 * fq;
#pragma unroll
            for (int ai = 0; ai < 2; ++ai)
#pragma unroll
                for (int m = 0; m < 4; ++m)
#pragma unroll
                    for (int bj = 0; bj < 2; ++bj) {
                        const f32x4 a = acc[ai][bj][m][0], b = acc[ai][bj][m][1];
                        u32x4 pk; pk[0] = cvt_pk_bf16(a[0], a[1]); pk[1] = cvt_pk_bf16(a[2], a[3]); pk[2] = cvt_pk_bf16(b[0], b[1]); pk[3] = cvt_pk_bf16(b[2], b[3]);
                        *(u32x4*)(PX + (size_t)(row0 + ai * HALF + m * 16) * PXW + col0 + bj * HALF) = pk;
                    }
        } else if (u.pn < 20) {
            const int col0 = (u.pn - 12) * 128 + wc * 32 + 8 * fq;
#pragma unroll
            for (int ai = 0; ai < 2; ++ai)
#pragma unroll
                for (int m = 0; m < 4; ++m) {
                    float o[8];
#pragma unroll
                    for (int n = 0; n < 2; ++n)
#pragma unroll
                        for (int i = 0; i < 4; ++i) o[n * 4 + i] = acc[ai][0][m][n][i] * sigmoid_f(acc[ai][1][m][n][i]);
                    u32x4 pk; pk[0] = cvt_pk_bf16(o[0], o[1]); pk[1] = cvt_pk_bf16(o[2], o[3]); pk[2] = cvt_pk_bf16(o[4], o[5]); pk[3] = cvt_pk_bf16(o[6], o[7]);
                    *(u32x4*)(U + (size_t)(row0 + ai * HALF + m * 16) * 1024 + col0) = pk;
                }
        } else {
            if (wc == 0) {
#pragma unroll
                for (int ai = 0; ai < 2; ++ai)
#pragma unroll
                    for (int m = 0; m < 4; ++m)
#pragma unroll
                        for (int n = 0; n < 2; ++n) *(f32x4*)(GK + (size_t)(row0 + ai * HALF + m * 16) * 32 + n * 16 + 4 * fq) = acc[ai][0][m][n];
            }
        }
    }
};

template <class Epi>
__device__ __forceinline__ void gemm_phase(LAS unsigned char* lds, const Gemm g, const Order& S, const Epi& E) {
    const int tid = otid(), wid = __builtin_amdgcn_readfirstlane(tid >> 6), lane = tid & 63, wr = wid >> 2, wc = wid & 3, fr = lane & 15, fq = lane >> 4;
    const int K = g.K;
    unsigned voffA[2];
#pragma unroll
    for (int i = 0; i < 2; ++i) { int R, C; stage_rc(tid * 16 + i * 8192, R, C); voffA[i] = (unsigned)(R * K + C) * 2u; }
    const size_t kstep = (size_t)(BK * 2);
    const size_t hstep = (size_t)HALF * K * 2;
    const size_t tstep = 2 * hstep;
    const unsigned ldsw = (unsigned)wid * 1024u;
    const int aoff = lds_byte(wr * 64 + fr, fq * 8), boff = lds_byte(wc * 32 + fr, fq * 8);
#define PG8_SA(b, h) (((b) * 2 + (h)) * HTB)
#define PG8_SB(b, h) ((4 + (b) * 2 + (h)) * HTB)
#define PG8_STAGE(bufoff, gbase) do { _Pragma("unroll") for (int _i = 0; _i < 2; ++_i) \
        __builtin_amdgcn_global_load_lds((const unsigned*)((const char*)(gbase) + voffA[_i]), (LAS unsigned*)(lds + (bufoff) + ldsw + _i * 8192), 16, 0, 0); } while (0)
#define PG8_LDA(dst, b, h) do { _Pragma("unroll") for (int m = 0; m < 4; ++m) _Pragma("unroll") for (int k = 0; k < 2; ++k) dst[m][k] = *(const LAS bf16x8*)(lds + PG8_SA(b, h) + aoff + m * 2048 + k * 1024); } while (0)
#define PG8_LDB(dst, b, h) do { _Pragma("unroll") for (int n = 0; n < 2; ++n) _Pragma("unroll") for (int k = 0; k < 2; ++k) dst[n][k] = *(const LAS bf16x8*)(lds + PG8_SB(b, h) + boff + n * 2048 + k * 1024); } while (0)
#define PG8_MMA(ai, bj, At, Bt) do { __builtin_amdgcn_s_setprio(1); _Pragma("unroll") for (int m = 0; m < 4; ++m) _Pragma("unroll") for (int n = 0; n < 2; ++n) _Pragma("unroll") for (int k = 0; k < 2; ++k) \
        acc[ai][bj][m][n] = __builtin_amdgcn_mfma_f32_16x16x32_bf16(Bt[n][k], At[m][k], acc[ai][bj][m][n], 0, 0, 0); __builtin_amdgcn_s_setprio(0); } while (0)
#define PG8_WAIT_V(n) asm volatile("s_waitcnt vmcnt(" #n ")" ::: "memory")
#define PG8_WAIT_L(n) asm volatile("s_waitcnt lgkmcnt(" #n ")" ::: "memory")
#define PG8_BAR __builtin_amdgcn_s_barrier()
#define PG8_SCHED __builtin_amdgcn_sched_barrier(0)
    Unit cur, nxt; int ui = 0;
    if (!S.next(0, cur)) return;
    f32x4 acc[2][2][4][2];
#pragma unroll
    for (int a = 0; a < 2; ++a)
#pragma unroll
        for (int b = 0; b < 2; ++b)
#pragma unroll
            for (int m = 0; m < 4; ++m)
#pragma unroll
                for (int n = 0; n < 2; ++n) acc[a][b][m][n] = (f32x4){0.f, 0.f, 0.f, 0.f};
    bf16x8 At[4][2], B0[2][2], B1[2][2];
    const char* cA = (const char*)g.A + (size_t)cur.pm * tstep + (size_t)cur.kt0 * kstep; const char* cB = (const char*)g.Bt + (size_t)cur.pn * tstep + (size_t)cur.kt0 * kstep;
    PG8_STAGE(PG8_SB(0, 0), cB); PG8_STAGE(PG8_SA(0, 0), cA); PG8_STAGE(PG8_SB(0, 1), cB + hstep); PG8_STAGE(PG8_SA(0, 1), cA + hstep);
    if (wr == 1) PG8_BAR;
    PG8_WAIT_V(4); PG8_BAR;
    PG8_STAGE(PG8_SB(1, 0), cB + kstep); PG8_STAGE(PG8_SA(1, 0), cA + kstep); PG8_STAGE(PG8_SB(1, 1), cB + hstep + kstep);
    PG8_WAIT_V(6); PG8_BAR;
    for (;;) {
        const bool has_next = S.next(ui + 1, nxt);
        const char* nA = has_next ? (const char*)g.A + (size_t)nxt.pm * tstep + (size_t)nxt.kt0 * kstep : cA; const char* nB = has_next ? (const char*)g.Bt + (size_t)nxt.pn * tstep + (size_t)nxt.kt0 * kstep : cB;
        const int nt = cur.nt;
        for (int t = 0; t < nt; t += 2) {
            const bool last = (t == nt - 2);
            const char* a1 = cA + (size_t)(t + 1) * kstep;
            const char* a2 = last ? nA : cA + (size_t)(t + 2) * kstep; const char* b2 = last ? nB : cB + (size_t)(t + 2) * kstep;
            const char* a3 = a2 + kstep; const char* b3 = b2 + kstep;
            PG8_LDB(B0, 0, 0); PG8_SCHED; PG8_LDA(At, 0, 0); PG8_STAGE(PG8_SA(1, 1), a1 + hstep);
            PG8_WAIT_L(8); PG8_BAR; PG8_WAIT_L(0); PG8_MMA(0, 0, At, B0); PG8_BAR; PG8_SCHED;
            PG8_LDB(B1, 0, 1); PG8_STAGE(PG8_SB(0, 0), b2);
            PG8_BAR; PG8_WAIT_L(0); PG8_MMA(0, 1, At, B1); PG8_BAR;
            PG8_LDA(At, 0, 1); PG8_STAGE(PG8_SA(0, 0), a2);
            PG8_BAR; PG8_WAIT_L(0); PG8_MMA(1, 0, At, B0); PG8_BAR; PG8_SCHED;
            PG8_STAGE(PG8_SB(0, 1), b2 + hstep);
            PG8_WAIT_V(6); PG8_BAR; PG8_MMA(1, 1, At, B1); PG8_BAR;
            PG8_LDB(B0, 1, 0); PG8_SCHED; PG8_LDA(At, 1, 0); PG8_STAGE(PG8_SA(0, 1), a2 + hstep);
            PG8_WAIT_L(8); PG8_BAR; PG8_WAIT_L(0); PG8_MMA(0, 0, At, B0); PG8_BAR; PG8_SCHED;
            PG8_LDB(B1, 1, 1); PG8_STAGE(PG8_SB(1, 0), b3);
            PG8_BAR; PG8_WAIT_L(0); PG8_MMA(0, 1, At, B1); PG8_BAR;
            PG8_LDA(At, 1, 1); PG8_STAGE(PG8_SA(1, 0), a3);
            PG8_BAR; PG8_WAIT_L(0); PG8_MMA(1, 0, At, B0); PG8_BAR; PG8_SCHED;
            PG8_STAGE(PG8_SB(1, 1), b3 + hstep);
            PG8_WAIT_V(6); PG8_BAR; PG8_MMA(1, 1, At, B1); PG8_BAR;
        }
        if (!E.defer(cur)) E(acc, cur, wr, wc, fr, fq);
        if (!has_next) break;
#pragma unroll
        for (int a = 0; a < 2; ++a)
#pragma unroll
            for (int b = 0; b < 2; ++b)
#pragma unroll
                for (int m = 0; m < 4; ++m)
#pragma unroll
                    for (int n = 0; n < 2; ++n) acc[a][b][m][n] = (f32x4){0.f, 0.f, 0.f, 0.f};
        cur = nxt; cA = nA; cB = nB; ++ui;
    }
    PG8_WAIT_V(0);
    if (wr == 0) PG8_BAR;
    PG8_BAR;
    if (E.defer(cur)) E.fused(acc, cur, wr, wc, fr, fq, lds, wid, lane);
#undef PG8_SA
#undef PG8_SB
#undef PG8_STAGE
#undef PG8_LDA
#undef PG8_LDB
#undef PG8_MMA
#undef PG8_WAIT_V
#undef PG8_WAIT_L
#undef PG8_BAR
#undef PG8_SCHED
}

__device__ __forceinline__ void gemv_item(const Params& p, LAS unsigned char* lds, int nt) {
    const int tid = otid();
    LAS float* sv = (LAS float*)lds;
    LAS float* red = sv + 3 * 2048;
    {
        float cvv[12];
#pragma unroll
        for (int q = 0; q < 12; ++q) { const int k = (tid + 512 * q) & 2047; cvv[q] = (q >> 2) < 2 ? p.c[(q >> 2) * 2048 + k] : p.c_ctx[k]; }
#pragma unroll
        for (int q = 0; q < 12; ++q) sv[tid + 512 * q] = cvv[q] / (1.f + __expf(-cvv[q]));
    }
    __syncthreads();
    const int cg4 = tid & 31, kl = tid >> 5;
    const float* wp = p.w_mod + (size_t)kl * NMOD + nt * 128 + cg4 * 4;
    f32x4 a0 = {0.f, 0.f, 0.f, 0.f}, a1 = a0, a2 = a0;
#pragma unroll 8
    for (int k = kl; k < 2048; k += 16) {
        const f32x4 w = __builtin_nontemporal_load((const f32x4*)wp); wp += (size_t)16 * NMOD;
        const float s0 = sv[k], s1 = sv[2048 + k], s2 = sv[4096 + k];
        a0 += w * s0; a1 += w * s1; a2 += w * s2;
    }
#pragma unroll
    for (int i = 0; i < 4; ++i) { red[(kl * 3 + 0) * 128 + cg4 * 4 + i] = a0[i]; red[(kl * 3 + 1) * 128 + cg4 * 4 + i] = a1[i]; red[(kl * 3 + 2) * 128 + cg4 * 4 + i] = a2[i]; }
    __syncthreads();
    if (tid < 384) {
        const int r = tid >> 7, col = tid & 127; float s = 0.f;
#pragma unroll
        for (int q = 0; q < 16; ++q) s += red[(q * 3 + r) * 128 + col];
        float* MOD = (float*)(p.ws + WS_MOD);
        MOD[r * NMOD + nt * 128 + col] = s + p.b_mod[nt * 128 + col];
    }
}

struct WcDesc { const float* src; bf16_t* dst; int K, Nsrc, perm, nvalid; };
__device__ __forceinline__ WcDesc wconv_decode(const Params& p, int it) {
    int w, loc;
    if (it < 1408) { w = 0; loc = it; } else if (it < 2112) { w = 1; loc = it - 1408; } else if (it < 2784) { w = 2; loc = it - 2112; }
    else if (it < 3040) { w = 3; loc = it - 2784; } else if (it < 4448) { w = 4; loc = it - 3040; } else { w = 5; loc = it - 4448; }
    const float* src; bf16_t* dst; int K, Nsrc, nR;
    switch (w) {
        case 0: src = p.w_ffn1_in; dst = (bf16_t*)(p.ws + WS_WT1); K = D; Nsrc = NFF; nR = 88; break;
        case 1: src = p.w_ffn1_out; dst = (bf16_t*)(p.ws + WS_WT2); K = DFF; Nsrc = D; nR = 16; break;
        case 2: src = p.w_in; dst = (bf16_t*)(p.ws + WS_WT3); K = D; Nsrc = NIN; nR = 42; break;
        case 3: src = p.w_out; dst = (bf16_t*)(p.ws + WS_WT4); K = D; Nsrc = D; nR = 16; break;
        case 4: src = p.w_ffn2_in; dst = (bf16_t*)(p.ws + WS_WT5); K = D; Nsrc = NFF; nR = 88; break;
        default: src = p.w_ffn2_out; dst = (bf16_t*)(p.ws + WS_WT6); K = DFF; Nsrc = D; nR = 16; break;
    }
    const int R = loc % nR, kt = loc / nR, k0 = kt * 128;
    int sbase, perm, nvalid = 128;
    if (w == 0 || w == 4) { sbase = (R & 1) * DFF + 128 * (R >> 1); perm = 1; }
    else if (w == 2) {
        if (R < 24) { sbase = 128 * R + (R >= 12 ? 32 : 0); perm = 1; }
        else if (R < 40) { const int q = R - 24; sbase = 3104 + (q & 1) * 1024 + 128 * (q >> 1); perm = 1; }
        else if (R == 40) { sbase = 1536; perm = 0; nvalid = 32; }
        else { sbase = 0; perm = 0; nvalid = 0; }
    } else { sbase = 128 * R; perm = 0; }
    WcDesc d; d.src = src + (size_t)k0 * Nsrc + sbase; d.dst = dst + (size_t)(128 * R) * K + k0; d.K = K; d.Nsrc = Nsrc; d.perm = perm; d.nvalid = nvalid;
    return d;
}
__device__ __forceinline__ void wconv_load(const WcDesc& d, int tid, f32x4 (&v)[2][4]) {
    const int cb = tid & 31;
#pragma unroll
    for (int iter = 0; iter < 2; ++iter) {
        const int kb = (tid >> 5) + 16 * iter;
#pragma unroll
        for (int kr = 0; kr < 4; ++kr) {
            if (4 * cb < d.nvalid) v[iter][kr] = __builtin_nontemporal_load((const f32x4*)(d.src + (size_t)(4 * kb + kr) * d.Nsrc + 4 * cb));
            else v[iter][kr] = (f32x4){0.f, 0.f, 0.f, 0.f};
        }
    }
}
__device__ __forceinline__ void wconv_lds(LAS unsigned char* lds, int tid, const f32x4 (&v)[2][4]) {
    const int cb = tid & 31;
#pragma unroll
    for (int iter = 0; iter < 2; ++iter) {
        const int kb = (tid >> 5) + 16 * iter;
#pragma unroll
        for (int ci = 0; ci < 4; ++ci) {
            u32x2 pk; pk[0] = cvt_pk_bf16(v[iter][0][ci], v[iter][1][ci]); pk[1] = cvt_pk_bf16(v[iter][2][ci], v[iter][3][ci]);
            *(LAS u32x2*)(lds + (4 * cb + ci) * 264 + 8 * kb) = pk;
        }
    }
}
__device__ __forceinline__ void wconv_out(const WcDesc& d, LAS unsigned char* lds, int tid) {
#pragma unroll
    for (int iter = 0; iter < 4; ++iter) {
        const int rr = (tid >> 4) + 32 * iter, kg = tid & 15;
        const int cc = d.perm ? ((rr & ~31) + perm32(rr & 31)) : rr;
        const u32x2 lo = *(const LAS u32x2*)(lds + cc * 264 + 16 * kg), hi = *(const LAS u32x2*)(lds + cc * 264 + 16 * kg + 8);
        u32x4 o; o[0] = lo[0]; o[1] = lo[1]; o[2] = hi[0]; o[3] = hi[1];
        *(u32x4*)(d.dst + (size_t)rr * d.K + 8 * kg) = o;
    }
}
template <class MAP>
__device__ __forceinline__ void wconv_run(const Params& p, LAS unsigned char* lds, int first, int stride, int nloc, MAP map) {
    const int tid = otid();
    if (first >= nloc) return;
    f32x4 va[2][4], vb[2][4];
    WcDesc da = wconv_decode(p, map(first)); wconv_load(da, tid, va);
    int itb = first + stride; bool hb = itb < nloc; WcDesc db = da;
    if (hb) { db = wconv_decode(p, map(itb)); wconv_load(db, tid, vb); }
    for (;;) {
        wconv_lds(lds, tid, va);
        __syncthreads();
        const int itc = itb + stride; const bool hc = hb && itc < nloc; WcDesc dc = da;
        if (hc) { dc = wconv_decode(p, map(itc)); wconv_load(dc, tid, va); }
        wconv_out(da, lds, tid);
        __syncthreads();
        if (!hb) break;
        wconv_lds(lds, tid, vb);
        __syncthreads();
        const int itd = itc + stride; const bool hd = hc && itd < nloc; WcDesc dd = db;
        if (hd) { dd = wconv_decode(p, map(itd)); wconv_load(dd, tid, vb); }
        wconv_out(db, lds, tid);
        __syncthreads();
        if (!hc) break;
        da = dc; db = dd; itb = itd; hb = hd;
    }
}

__device__ __forceinline__ void phase_prep_weights(const Params& p, LAS unsigned char* lds) {
    for (int it = blockIdx.x; it < 128; it += gridDim.x) { gemv_item(p, lds, it); __syncthreads(); }
    const int G = gridDim.x; const int c = (int)((blockIdx.x + G - (128 % G)) % G);
    wconv_run(p, lds, c, G, 1408 + 672, [](int i) { return i < 1408 ? i : i - 1408 + 2112; });
}
__device__ __forceinline__ void wconv_tail(const Params& p, LAS unsigned char* lds, int nunits, int it0, int it1) {
    const int G = gridDim.x, first_idle = nunits % G, nidle = G - first_idle, c = blockIdx.x;
    if (c >= first_idle) wconv_run(p, lds, c - first_idle, nidle, it1 - it0, [it0](int i) { return i + it0; });
}

template <int MODE>
__device__ __forceinline__ void phase_modnorm(const Params& p, int row_begin, int nrows, const float* gain, int shift_idx, int scale_idx) {
    const int tid_ = otid(); const int wave = tid_ >> 6, lane = tid_ & 63;
    const float* MOD = (const float*)(p.ws + WS_MOD);
    const float* H1 = (const float*)(p.ws + WS_H1);
    bf16_t* ACT = (bf16_t*)(p.ws + WS_ACT);
    for (int row = row_begin + blockIdx.x * 8 + wave; row < nrows; row += gridDim.x * 8) {
        const float* src = MODE == 0 ? (row < TL ? p.x + (size_t)row * D : p.ctx + (size_t)(row - TL) * D) : (row < TL ? H1 + (size_t)row * D : p.ctx + (size_t)(row - TL) * D);
        const int set = row < 4096 ? 0 : (row < 8192 ? 1 : 2);
        const float* md = MOD + (size_t)set * NMOD;
        f32x4 v[8]; float ss = 0.f;
#pragma unroll
        for (int i = 0; i < 8; ++i) {
            v[i] = *(const f32x4*)(src + (i * 64 + lane) * 4);
            if (MODE == 1 && row >= TL) {
                const float* pp = (const float*)(p.ws + WS_PART) + (size_t)(row - TL) * D + (i * 64 + lane) * 4;
                f32x4 a = *(const f32x4*)pp;
#pragma unroll
                for (int ks = 1; ks < 11; ++ks) a += *(const f32x4*)(pp + (size_t)ks * TCX * D);
                v[i] += a * (*(const f32x4*)(md + 2 * D + (i * 64 + lane) * 4)) * 0.5f;
            }
            ss += v[i][0] * v[i][0] + v[i][1] * v[i][1] + v[i][2] * v[i][2] + v[i][3] * v[i][3]; }
        f32x4 gq[8], scq[8], shq[8];
#pragma unroll
        for (int i = 0; i < 8; ++i) {
            const int col = (i * 64 + lane) * 4;
            gq[i] = *(const f32x4*)(gain + col); scq[i] = *(const f32x4*)(md + scale_idx * D + col); shq[i] = *(const f32x4*)(md + shift_idx * D + col);
        }
        ss = wave_sum(ss);
        const float rs = rsqrtf(ss * (1.f / 2048.f) + 1e-6f);
#pragma unroll
        for (int i = 0; i < 8; ++i) {
            const int col = (i * 64 + lane) * 4;
            const f32x4 o = v[i] * rs * gq[i] * (scq[i] + 1.f) + shq[i];
            u32x2 pk; pk[0] = cvt_pk_bf16(o[0], o[1]); pk[1] = cvt_pk_bf16(o[2], o[3]);
            *(u32x2*)(ACT + (size_t)row * D + col) = pk;
        }
    }
}
__device__ __forceinline__ void phase_ctxnorm(const Params& p, LAS unsigned char* lds) {
    const int tid_ = otid(); const int wave = tid_ >> 6, lane = tid_ & 63, r = wave >> 2, qtr = wave & 3;
    const float* md = (const float*)(p.ws + WS_MOD) + (size_t)2 * NMOD;
    const float* PART = (const float*)(p.ws + WS_PART);
    bf16_t* ACT = (bf16_t*)(p.ws + WS_ACT);
    LAS float* red = (LAS float*)lds;
    for (int rp = blockIdx.x; rp < TCX / 2; rp += gridDim.x) {
        const int rc = rp * 2 + r;
        f32x4 v[2], a[2], m2[2]; f32x4 pr[2][11];
#pragma unroll
        for (int i = 0; i < 2; ++i) {
            const int col = qtr * 512 + (i * 64 + lane) * 4;
            v[i] = *(const f32x4*)(p.ctx + (size_t)rc * D + col);
            m2[i] = *(const f32x4*)(md + 2 * D + col);
#pragma unroll
            for (int ks = 0; ks < 11; ++ks) pr[i][ks] = *(const f32x4*)(PART + ((size_t)ks * TCX + rc) * D + col);
        }
        float ss = 0.f;
#pragma unroll
        for (int i = 0; i < 2; ++i) {
            a[i] = pr[i][0];
#pragma unroll
            for (int ks = 1; ks < 11; ++ks) a[i] += pr[i][ks];
            v[i] += a[i] * m2[i] * 0.5f;
            ss += v[i][0] * v[i][0] + v[i][1] * v[i][1] + v[i][2] * v[i][2] + v[i][3] * v[i][3];
        }
        ss = wave_sum(ss);
        if (lane == 0) red[wave] = ss;
        __syncthreads();
        const float tot = (red[r * 4] + red[r * 4 + 1]) + (red[r * 4 + 2] + red[r * 4 + 3]);
        const float rs = rsqrtf(tot * (1.f / 2048.f) + 1e-6f);
#pragma unroll
        for (int i = 0; i < 2; ++i) {
            const int col = qtr * 512 + (i * 64 + lane) * 4;
            const f32x4 g = *(const f32x4*)(p.norm_mix + col), sc = *(const f32x4*)(md + 4 * D + col), sh = *(const f32x4*)(md + 3 * D + col);
            const f32x4 o = v[i] * rs * g * (sc + 1.f) + sh;
            u32x2 pk; pk[0] = cvt_pk_bf16(o[0], o[1]); pk[1] = cvt_pk_bf16(o[2], o[3]);
            *(u32x2*)(ACT + (size_t)(TL + rc) * D + col) = pk;
        }
        __syncthreads();
    }
}
__device__ __forceinline__ void phase_final(const Params& p) {
    const int tid_ = otid(); const int wave = tid_ >> 6, lane = tid_ & 63;
    const float* H1 = (const float*)(p.ws + WS_H1);
    for (int row = blockIdx.x * 8 + wave; row < TL; row += gridDim.x * 8) {
        const float* src = H1 + (size_t)row * D;
        f32x4 v[8]; float ss = 0.f;
#pragma unroll
        for (int i = 0; i < 8; ++i) { v[i] = *(const f32x4*)(src + (i * 64 + lane) * 4); ss += v[i][0] * v[i][0] + v[i][1] * v[i][1] + v[i][2] * v[i][2] + v[i][3] * v[i][3]; }
        ss = wave_sum(ss);
        const float rs = rsqrtf(ss * (1.f / 2048.f) + 1e-6f);
#pragma unroll
        for (int i = 0; i < 8; ++i) {
            const int col = (i * 64 + lane) * 4;
            const f32x4 g = *(const f32x4*)(p.norm_final + col);
            *(f32x4*)(p.out + (size_t)row * D + col) = v[i] * rs * g;
        }
    }
}

constexpr int L_GKS = 0;
constexpr int L_BC = 8192;
constexpr int L_VT = L_BC + 33024;
constexpr int L_T0 = L_VT + 36864;
constexpr int L_QS = L_T0, L_KS = L_T0 + 17408, L_QE = L_T0 + 2 * 17408, L_ATT = L_T0 + 3 * 17408, L_RED = L_ATT + 9216;
constexpr int L_TOT = L_RED + 2048;
static_assert(L_TOT + 4096 <= LDS_BYTES - 16, "LDS");

__device__ __forceinline__ void gla_stage_common(const Params& p, LAS unsigned char* lds, int row0, int h) {
    const int tid = otid();
    const float* GK = (const float*)(p.ws + WS_GK);
    const bf16_t* PX = (const bf16_t*)(p.ws + WS_PX);
    const int t4 = tid & 15, eg = tid >> 4;
    const f32x4 gkv = *(const f32x4*)(GK + (size_t)(row0 + (tid >> 3)) * 32 + (tid & 7) * 4);
    u32x4 vv[4];
#pragma unroll
    for (int i = 0; i < 4; ++i) vv[i] = *(const u32x4*)(PX + (size_t)(row0 + 4 * t4 + i) * PXW + 512 + h * 256 + eg * 8);
    asm volatile("" :: "v"(gkv), "v"(vv[0]), "v"(vv[1]), "v"(vv[2]), "v"(vv[3]));
    *(LAS f32x4*)(lds + L_GKS + ((tid >> 3) * 32 + (tid & 7) * 4) * 4) = gkv;
#pragma unroll
    for (int k = 0; k < 4; ++k) {
        u32x2 lo, hi;
        lo[0] = (vv[0][k] & 0xffffu) | (vv[1][k] << 16); lo[1] = (vv[2][k] & 0xffffu) | (vv[3][k] << 16);
        hi[0] = (vv[0][k] >> 16) | (vv[1][k] & 0xffff0000u); hi[1] = (vv[2][k] >> 16) | (vv[3][k] & 0xffff0000u);
        *(LAS u32x2*)(lds + L_VT + ((eg * 8 + 2 * k) * 72 + 4 * t4) * 2) = lo;
        *(LAS u32x2*)(lds + L_VT + ((eg * 8 + 2 * k + 1) * 72 + 4 * t4) * 2) = hi;
    }
}
__device__ __forceinline__ void gla_load_w2(const Params& p, int h, int d, int tid, float (&w2r)[16], float& b2) {
    const int j = tid & 127;
#pragma unroll
    for (int r = 0; r < 16; ++r) w2r[r] = p.w_gk2[(size_t)(d * 16 + r) * 512 + h * 128 + j];
    b2 = p.b_gk2[d * 512 + h * 128 + j];
}
__device__ __forceinline__ void gla_logdecay16w(LAS unsigned char* lds, int d, int tid, const float (&w2r)[16], float b2, float (&ld)[16]) {
    const int seg = tid >> 7;
    LAS float* gks = (LAS float*)(lds + L_GKS);
#pragma unroll
    for (int tt = 0; tt < 16; ++tt) {
        const int t = 16 * seg + tt;
        float z = b2;
#pragma unroll
        for (int r4 = 0; r4 < 4; ++r4) {
            const f32x4 gv = *(const LAS f32x4*)(gks + t * 32 + d * 16 + r4 * 4);
            z += gv[0] * w2r[r4 * 4] + gv[1] * w2r[r4 * 4 + 1] + gv[2] * w2r[r4 * 4 + 2] + gv[3] * w2r[r4 * 4 + 3];
        }
        const float e2 = __builtin_amdgcn_exp2f(fabsf(z) * -1.4426950408889634f);
        ld[tt] = fminf(z, 0.f) * (1.f / 16.f) - 0.04332169878499658f * __builtin_amdgcn_logf(1.f + e2);
    }
}
__device__ __forceinline__ void gla_logdecay16(const Params& p, LAS unsigned char* lds, int h, int d, int tid, float (&ld)[16]) {
    float w2r[16], b2; gla_load_w2(p, h, d, tid, w2r, b2); gla_logdecay16w(lds, d, tid, w2r, b2, ld);
}
__device__ __forceinline__ void gla_cumdecay(const Params& p, LAS unsigned char* lds, int h, int d) {
    const int tid = otid(), j = tid & 127, seg = tid >> 7;
    LAS float* bc = (LAS float*)(lds + L_BC);
    LAS float* tot = (LAS float*)(lds + L_TOT);
    float ld[16];
    gla_logdecay16(p, lds, h, d, tid, ld);
    float run = 0.f;
    if (d == 0) {
#pragma unroll
        for (int tt = 0; tt < 16; ++tt) { run += ld[tt]; ld[tt] = run; }
    } else {
#pragma unroll
        for (int tt = 15; tt >= 0; --tt) { run += ld[tt]; ld[tt] = run; }
    }
    tot[seg * 128 + j] = run;
    __syncthreads();
    float off = 0.f;
#pragma unroll
    for (int sg = 0; sg < 4; ++sg) { const float tv = tot[sg * 128 + j]; const bool use = d == 0 ? (sg < seg) : (sg > seg); off += use ? tv : 0.f; }
#pragma unroll
    for (int tt = 0; tt < 16; ++tt) bc[(16 * seg + tt) * 129 + j] = ld[tt] + off;
    __syncthreads();
}

__device__ __forceinline__ void gla_a_item(const Params& p, LAS unsigned char* lds, int item, int dsel) {
    const int tid = otid(), wid = tid >> 6, lane = tid & 63, fr = lane & 15, fq = lane >> 4;
    const int bh = item / NSLOT, slot = item % NSLOT, b = bh >> 2, h = bh & 3;
    const int row0 = slot < 4 ? TL + b * 256 + slot * 64 : b * 4096 + (slot - 4) * 64;
    const bf16_t* PX = (const bf16_t*)(p.ws + WS_PX);
    bf16_t* KVT = (bf16_t*)(p.ws + WS_HID);
    float* DEC = (float*)(p.ws + WS_DEC);
    LAS float* tot = (LAS float*)(lds + L_TOT);
    const int j = tid & 127, seg = tid >> 7;
    gla_stage_common(p, lds, row0, h);
    float kf[16];
#pragma unroll
    for (int tt = 0; tt < 16; ++tt) kf[tt] = bf_lo((unsigned)PX[(size_t)(row0 + 16 * seg + tt) * PXW + h * 128 + j]);
    float w2f[16], w2b[16], b2f, b2b;
    gla_load_w2(p, h, 0, tid, w2f, b2f); gla_load_w2(p, h, 1, tid, w2b, b2b);
    __syncthreads();
    const bool do_f = dsel != 2, do_b = dsel != 1;
    float lf[16], lb[16];
    if (do_f) gla_logdecay16w(lds, 0, tid, w2f, b2f, lf); else {
#pragma unroll
        for (int q = 0; q < 16; ++q) lf[q] = 0.f; }
    if (do_b) gla_logdecay16w(lds, 1, tid, w2b, b2b, lb); else {
#pragma unroll
        for (int q = 0; q < 16; ++q) lb[q] = 0.f; }
    float tf = 0.f, tb = 0.f;
#pragma unroll
    for (int tt = 15; tt >= 0; --tt) { const float v = lf[tt]; lf[tt] = tf; tf += v; }
#pragma unroll
    for (int tt = 0; tt < 16; ++tt) { const float v = lb[tt]; lb[tt] = tb; tb += v; }
    tot[seg * 128 + j] = tf; tot[512 + seg * 128 + j] = tb;
    __syncthreads();
    float of = 0.f, ob = 0.f, sf = 0.f, sb = 0.f;
#pragma unroll
    for (int sg = 0; sg < 4; ++sg) { const float a = tot[sg * 128 + j], c = tot[512 + sg * 128 + j]; sf += a; sb += c; of += sg > seg ? a : 0.f; ob += sg < seg ? c : 0.f; }
    if (do_f) {
        u32x4 w0, w1;
#pragma unroll
        for (int q = 0; q < 4; ++q) {
            w0[q] = cvt_pk_bf16(kf[2 * q] * __expf(lf[2 * q] + of), kf[2 * q + 1] * __expf(lf[2 * q + 1] + of));
            w1[q] = cvt_pk_bf16(kf[8 + 2 * q] * __expf(lf[8 + 2 * q] + of), kf[8 + 2 * q + 1] * __expf(lf[8 + 2 * q + 1] + of));
        }
        *(LAS u32x4*)(lds + L_T0 + (j * 72 + 16 * seg) * 2) = w0; *(LAS u32x4*)(lds + L_T0 + (j * 72 + 16 * seg + 8) * 2) = w1;
    }
    if (do_b) {
        u32x4 w2, w3;
#pragma unroll
        for (int q = 0; q < 4; ++q) {
            w2[q] = cvt_pk_bf16(kf[2 * q] * __expf(lb[2 * q] + ob), kf[2 * q + 1] * __expf(lb[2 * q + 1] + ob));
            w3[q] = cvt_pk_bf16(kf[8 + 2 * q] * __expf(lb[8 + 2 * q] + ob), kf[8 + 2 * q + 1] * __expf(lb[8 + 2 * q + 1] + ob));
        }
        *(LAS u32x4*)(lds + L_T0 + 18432 + (j * 72 + 16 * seg) * 2) = w2; *(LAS u32x4*)(lds + L_T0 + 18432 + (j * 72 + 16 * seg + 8) * 2) = w3;
    }
    if (slot >= 4) {
        float bef = 0.f, aft = 0.f;
#pragma unroll
        for (int sg = 0; sg < 4; ++sg) { bef += sg < seg ? tot[sg * 128 + j] : 0.f; aft += sg > seg ? tot[512 + sg * 128 + j] : 0.f; }
        float* bcf = (float*)(p.ws + WS_BC) + (((size_t)(0 * 8 + bh) * 64 + (slot - 4)) * 64 + 16 * seg) * 128 + j;
        float* bcb = (float*)(p.ws + WS_BC) + (((size_t)(1 * 8 + bh) * 64 + (slot - 4)) * 64 + 16 * seg) * 128 + j;
#pragma unroll
        for (int tt = 0; tt < 16; ++tt) { if (do_f) bcf[tt * 128] = (tf - lf[tt]) + bef; if (do_b) bcb[tt * 128] = (tb - lb[tt]) + aft; }
        bf16_t* vtg = (bf16_t*)(p.ws + WS_VT) + ((size_t)bh * 64 + (slot - 4)) * 256 * 64;
        if (do_f)
#pragma unroll
        for (int it = 0; it < 4; ++it) {
            const int id = tid + 512 * it, e = id >> 3, cq = id & 7;
            *(u32x4*)(vtg + e * 64 + cq * 8) = *(const LAS u32x4*)(lds + L_VT + e * 144 + cq * 16);
        }
    }
    if (seg == 0 && do_f) DEC[((size_t)(0 * 8 + bh) * NSLOT + slot) * 128 + j] = __expf(sf);
    if (seg == 1 && do_b) DEC[((size_t)(1 * 8 + bh) * NSLOT + slot) * 128 + j] = __expf(sb);
    __syncthreads();
    for (int d = 0; d < 2; ++d) {
        if (d == 0 ? !do_f : !do_b) continue;
        f32x4 acc[2][8];
#pragma unroll
        for (int et = 0; et < 2; ++et)
#pragma unroll
            for (int jt = 0; jt < 8; ++jt) acc[et][jt] = (f32x4){0.f, 0.f, 0.f, 0.f};
#pragma unroll
        for (int ks = 0; ks < 2; ++ks) {
            bf16x8 bv[2];
#pragma unroll
            for (int et = 0; et < 2; ++et) bv[et] = *(const LAS bf16x8*)(lds + L_VT + (32 * wid + 16 * et + fr) * 144 + (ks * 32 + fq * 8) * 2);
#pragma unroll
            for (int jt = 0; jt < 8; ++jt) {
                const bf16x8 av = *(const LAS bf16x8*)(lds + L_T0 + d * 18432 + (16 * jt + fr) * 144 + (ks * 32 + fq * 8) * 2);
#pragma unroll
                for (int et = 0; et < 2; ++et) acc[et][jt] = __builtin_amdgcn_mfma_f32_16x16x32_bf16(av, bv[et], acc[et][jt], 0, 0, 0);
            }
        }
        bf16_t* kvb = KVT + ((size_t)(d * 8 + bh) * NSLOT + slot) * 32768;
#pragma unroll
        for (int et = 0; et < 2; ++et)
#pragma unroll
            for (int jt = 0; jt < 8; ++jt) {
                u32x2 pk; pk[0] = cvt_pk_bf16(acc[et][jt][0], acc[et][jt][1]); pk[1] = cvt_pk_bf16(acc[et][jt][2], acc[et][jt][3]);
                *(u32x2*)(kvb + (32 * wid + 16 * et + fr) * 128 + 16 * jt + 4 * fq) = pk;
            }
    }
}

template <int NT>
__device__ __forceinline__ void conv_window(const bf16_t* ubase, size_t stride_el, int p0, const LAS float* cwl, float (*y)[8]) {
    constexpr int PFD = 8;
    float wv[NT][8]; u32x4 pf[PFD];
    const bf16_t* ptr = ubase + (ptrdiff_t)p0 * (ptrdiff_t)stride_el;
#pragma unroll
    for (int q = 0; q < NT; ++q) {
        u32x4 v = *(const u32x4*)ptr; ptr += stride_el;
        const int pos = p0 + q; if (pos < 0 || pos > 63) v = (u32x4){0u, 0u, 0u, 0u};
#pragma unroll
        for (int i = 0; i < 4; ++i) { wv[q][2 * i] = bf_lo(v[i]); wv[q][2 * i + 1] = bf_hi(v[i]); }
    }
#pragma unroll
    for (int q = 0; q < PFD; ++q) { pf[q] = *(const u32x4*)ptr; ptr += stride_el; }
#pragma unroll 1
    for (int j0 = 0; j0 < 32; j0 += 8) {
#pragma unroll
        for (int jj = 0; jj < 8; ++jj) {
            const int j = j0 + jj;
            const f32x4 c0 = *(const LAS f32x4*)(cwl + j * 1024), c1 = *(const LAS f32x4*)(cwl + j * 1024 + 4);
#pragma unroll
            for (int tk = 0; tk < NT; ++tk) {
                const float (&w)[8] = wv[(tk + jj) % NT];
                y[tk][0] += w[0] * c0[0]; y[tk][1] += w[1] * c0[1]; y[tk][2] += w[2] * c0[2]; y[tk][3] += w[3] * c0[3];
                y[tk][4] += w[4] * c1[0]; y[tk][5] += w[5] * c1[1]; y[tk][6] += w[6] * c1[2]; y[tk][7] += w[7] * c1[3];
            }
            {
                u32x4 v = pf[jj];
                const int pos = p0 + NT + j; if (pos < 0 || pos > 63) v = (u32x4){0u, 0u, 0u, 0u};
                float (&w)[8] = wv[jj % NT];
#pragma unroll
                for (int i = 0; i < 4; ++i) { w[2 * i] = bf_lo(v[i]); w[2 * i + 1] = bf_hi(v[i]); }
            }
            pf[jj] = *(const u32x4*)ptr; ptr += stride_el;
        }
    }
}
__device__ __forceinline__ void conv_item(const Params& p, LAS unsigned char* lds, int item) {
    const int tid = otid(), wid = tid >> 6;
    const int b = item >> 7, r0 = ((item >> 3) & 15) * 4, w0 = (item & 7) * 8;
    const bf16_t* U = (const bf16_t*)(p.ws + WS_U);
    bf16_t* OCAT = (bf16_t*)(p.ws + WS_ACT);
    LAS float* red = (LAS float*)lds;
    const int cg = tid & 127, ch = cg * 8, tg = tid >> 7;
    const bool rowconv = cg < 64;
    float bias[8], lg[8], lb[8];
    { const f32x4 b0 = *(const f32x4*)(p.conv_b + ch), b1 = *(const f32x4*)(p.conv_b + ch + 4);
      const f32x4 g0 = *(const f32x4*)(p.conv_ln_g + ch), g1 = *(const f32x4*)(p.conv_ln_g + ch + 4);
      const f32x4 l0 = *(const f32x4*)(p.conv_ln_b + ch), l1 = *(const f32x4*)(p.conv_ln_b + ch + 4);
#pragma unroll
      for (int i = 0; i < 4; ++i) { bias[i] = b0[i]; bias[4 + i] = b1[i]; lg[i] = g0[i]; lg[4 + i] = g1[i]; lb[i] = l0[i]; lb[4 + i] = l1[i]; } }
    LAS float* cwl = (LAS float*)(lds + 512);
    {
        f32x4 cwv[16];
#pragma unroll
        for (int q = 0; q < 16; ++q) { const int i = tid + 512 * q; const int ic = i < 31 * 256 ? i : 0; cwv[q] = *(const f32x4*)(p.conv_w + ic * 4); if (i >= 31 * 256) cwv[q] = (f32x4){0.f, 0.f, 0.f, 0.f}; }
#pragma unroll
        for (int q = 0; q < 16; ++q) *(LAS f32x4*)(cwl + (tid + 512 * q) * 4) = cwv[q];
    }
    __syncthreads();
    float y[8][8];
#pragma unroll
    for (int tk = 0; tk < 8; ++tk)
#pragma unroll
        for (int i = 0; i < 8; ++i) y[tk][i] = bias[i];
    int ltok[8];
    if (rowconv) {
        conv_window<8>(U + (size_t)(b * 4096 + (r0 + tg) * 64) * 1024 + ch, 1024, w0 - 15, cwl + ch, &y[0]);
#pragma unroll
        for (int tk = 0; tk < 8; ++tk) ltok[tk] = tg * 8 + tk;
    } else {
        conv_window<4>(U + (size_t)(b * 4096 + w0 + 2 * tg) * 1024 + ch, 64 * 1024, r0 - 15, cwl + ch, &y[0]);
        conv_window<4>(U + (size_t)(b * 4096 + w0 + 2 * tg + 1) * 1024 + ch, 64 * 1024, r0 - 15, cwl + ch, &y[4]);
#pragma unroll
        for (int tk = 0; tk < 8; ++tk) ltok[tk] = (tk & 3) * 8 + 2 * tg + (tk >> 2);
    }
    const int half = rowconv ? 0 : 1;
#pragma unroll
    for (int tk = 0; tk < 8; ++tk) {
        float s1 = 0.f, s2 = 0.f;
#pragma unroll
        for (int i = 0; i < 8; ++i) { s1 += y[tk][i]; s2 += y[tk][i] * y[tk][i]; }
        s1 = wave_sum(s1); s2 = wave_sum(s2);
        if ((tid & 63) == 0) { red[(ltok[tk] * 2 + half) * 2] = s1; red[(ltok[tk] * 2 + half) * 2 + 1] = s2; }
    }
    __syncthreads();
#pragma unroll
    for (int tk = 0; tk < 8; ++tk) {
        const int lt = ltok[tk];
        const float mean = (red[lt * 4] + red[lt * 4 + 2]) * (1.f / 1024.f);
        const float var = (red[lt * 4 + 1] + red[lt * 4 + 3]) * (1.f / 1024.f) - mean * mean;
        const float rstd = rsqrtf(fmaxf(var, 0.f) + 1e-5f);
        float o[8];
#pragma unroll
        for (int i = 0; i < 8; ++i) { const float yn = (y[tk][i] - mean) * rstd * lg[i] + lb[i]; o[i] = silu_f(yn); }
        u32x4 pk; pk[0] = cvt_pk_bf16(o[0], o[1]); pk[1] = cvt_pk_bf16(o[2], o[3]); pk[2] = cvt_pk_bf16(o[4], o[5]); pk[3] = cvt_pk_bf16(o[6], o[7]);
        const int tok = b * 4096 + (r0 + (lt >> 3)) * 64 + w0 + (lt & 7);
        if (DBG_ZERO_CONV) { pk[0] = 0; pk[1] = 0; pk[2] = 0; pk[3] = 0; }
        *(u32x4*)(OCAT + (size_t)tok * D + 1024 + ch) = pk;
    }
    (void)wid;
}

__device__ __forceinline__ void phase_gla_a_conv(const Params& p, LAS unsigned char* lds) {
    const int nItems = 256 + 512 + 64;
    for (int it = blockIdx.x; it < nItems; it += gridDim.x) {
        if (it < 256) conv_item(p, lds, it);
        else if (it < 768) gla_a_item(p, lds, it - 256, 0);
        else { const int hh = it - 768; gla_a_item(p, lds, 512 + (hh >> 1), 1 + (hh & 1)); }
        __syncthreads();
    }
}

template <int DIR>
__device__ __forceinline__ void scan_one(bf16_t* base, const float* db) {
    f32x4 S = {0.f, 0.f, 0.f, 0.f};
    {
        u32x2 kv[4]; f32x4 dc[4];
#pragma unroll
        for (int q = 0; q < 4; ++q) { const int slot = DIR == 0 ? q : 3 - q; kv[q] = *(const u32x2*)(base + (size_t)slot * 32768); dc[q] = *(const f32x4*)(db + slot * 128); }
#pragma unroll
        for (int q = 0; q < 4; ++q) { S[0] = dc[q][0] * S[0] + bf_lo(kv[q][0]); S[1] = dc[q][1] * S[1] + bf_hi(kv[q][0]); S[2] = dc[q][2] * S[2] + bf_lo(kv[q][1]); S[3] = dc[q][3] * S[3] + bf_hi(kv[q][1]); }
    }
#pragma unroll 1
    for (int b0 = 0; b0 < 64; b0 += 16) {
        u32x2 kv[16]; f32x4 dc[16];
#pragma unroll
        for (int q = 0; q < 16; ++q) { const int slot = DIR == 0 ? 4 + b0 + q : 67 - b0 - q; kv[q] = *(const u32x2*)(base + (size_t)slot * 32768); dc[q] = *(const f32x4*)(db + slot * 128); }
#pragma unroll
        for (int q = 0; q < 16; ++q) {
            const int slot = DIR == 0 ? 4 + b0 + q : 67 - b0 - q;
            u32x2 pk; pk[0] = cvt_pk_bf16(S[0], S[1]); pk[1] = cvt_pk_bf16(S[2], S[3]);
            *(u32x2*)(base + (size_t)slot * 32768) = pk;
            S[0] = dc[q][0] * S[0] + bf_lo(kv[q][0]); S[1] = dc[q][1] * S[1] + bf_hi(kv[q][0]); S[2] = dc[q][2] * S[2] + bf_lo(kv[q][1]); S[3] = dc[q][3] * S[3] + bf_hi(kv[q][1]);
        }
    }
}
__device__ __forceinline__ void phase_scan(const Params& p) {
    bf16_t* KVT = (bf16_t*)(p.ws + WS_HID);
    const float* DEC = (const float*)(p.ws + WS_DEC);
    for (int gid = blockIdx.x * 512 + otid(); gid < 2 * 8 * 256 * 32; gid += gridDim.x * 512) {
        const int d = gid >> 16, bh = (gid >> 13) & 7, e = (gid >> 5) & 255, jg = gid & 31;
        bf16_t* base = KVT + (size_t)(d * 8 + bh) * NSLOT * 32768 + e * 128 + jg * 4;
        const float* db = DEC + (size_t)(d * 8 + bh) * NSLOT * 128 + jg * 4;
        if (d == 0) scan_one<0>(base, db); else scan_one<1>(base, db);
    }
}

__device__ __forceinline__ void gla_c_item(const Params& p, LAS unsigned char* lds, int item) {
    const int tid = otid(), wid = tid >> 6, lane = tid & 63, fr = lane & 15, fq = lane >> 4;
    const int bh = item >> 6, n = item & 63, b = bh >> 2, h = bh & 3, slot = 4 + n;
    const int row0 = b * 4096 + n * 64;
    const bf16_t* PX = (const bf16_t*)(p.ws + WS_PX);
    const bf16_t* KVT = (const bf16_t*)(p.ws + WS_HID);
    bf16_t* OCAT = (bf16_t*)(p.ws + WS_ACT);
    LAS float* bc = (LAS float*)(lds + L_BC);
    const float* bcg = (const float*)(p.ws + WS_BC) + ((size_t)bh * 64 + n) * 64 * 128;
    f32x4 bcv[2][4];
#pragma unroll
    for (int d = 0; d < 2; ++d)
#pragma unroll
        for (int it = 0; it < 4; ++it) bcv[d][it] = *(const f32x4*)(bcg + (size_t)d * 8 * 64 * 64 * 128 + (size_t)(tid + 512 * it) * 4);
    const bf16_t* vtg = (const bf16_t*)(p.ws + WS_VT) + ((size_t)bh * 64 + n) * 256 * 64;
    bf16x8 vfr[2][2];
#pragma unroll
    for (int ks = 0; ks < 2; ++ks)
#pragma unroll
        for (int et = 0; et < 2; ++et) vfr[ks][et] = *(const bf16x8*)(vtg + (32 * wid + 16 * et + fr) * 64 + ks * 32 + fq * 8);
    f32x4 o[2][4];
#pragma unroll
    for (int et = 0; et < 2; ++et)
#pragma unroll
        for (int tt = 0; tt < 4; ++tt) o[et][tt] = (f32x4){0.f, 0.f, 0.f, 0.f};
    for (int d = 0; d < 2; ++d) {
#pragma unroll
        for (int it = 0; it < 4; ++it) {
            const int id = tid + 512 * it, t = id >> 5, j4 = (id & 31) * 4;
            const f32x4 v = d == 0 ? bcv[0][it] : bcv[1][it];
            bc[t * 129 + j4] = v[0]; bc[t * 129 + j4 + 1] = v[1]; bc[t * 129 + j4 + 2] = v[2]; bc[t * 129 + j4 + 3] = v[3];
        }
        __syncthreads();
        const int tm = d == 0 ? 31 : 32;
        { const int t = tid & 63;
#pragma unroll
          for (int it = 0; it < 2; ++it) {
              const int jg = (tid >> 6) + 8 * it;
              const u32x4 qv = *(const u32x4*)(PX + (size_t)(row0 + t) * PXW + 1536 + h * 128 + jg * 8);
              const u32x4 kv = *(const u32x4*)(PX + (size_t)(row0 + t) * PXW + h * 128 + jg * 8);
              float qs[8], ks[8], qe[8];
#pragma unroll
              for (int i = 0; i < 8; ++i) {
                  const int j = jg * 8 + i;
                  const float qf = ((i & 1) ? bf_hi(qv[i >> 1]) : bf_lo(qv[i >> 1])) * 0.08838834764831845f;
                  const float kf = (i & 1) ? bf_hi(kv[i >> 1]) : bf_lo(kv[i >> 1]);
                  const float bb = bc[t * 129 + j], bm = bc[tm * 129 + j];
                  qs[i] = qf * __expf(bb - bm); ks[i] = kf * __expf(bm - bb); qe[i] = qf * __expf(bb);
              }
              u32x4 a, c, e;
#pragma unroll
              for (int i = 0; i < 4; ++i) { a[i] = cvt_pk_bf16(qs[2 * i], qs[2 * i + 1]); c[i] = cvt_pk_bf16(ks[2 * i], ks[2 * i + 1]); e[i] = cvt_pk_bf16(qe[2 * i], qe[2 * i + 1]); }
              *(LAS u32x4*)(lds + L_QS + t * 272 + jg * 16) = a;
              *(LAS u32x4*)(lds + L_KS + t * 272 + jg * 16) = c;
              *(LAS u32x4*)(lds + L_QE + t * 272 + jg * 16) = e;
          } }
        __syncthreads();
        { const int tt = wid & 3;
#pragma unroll
          for (int sh = 0; sh < 2; ++sh) {
              const int st = (wid >> 2) * 2 + sh;
              f32x4 a = {0.f, 0.f, 0.f, 0.f};
#pragma unroll
              for (int ks = 0; ks < 4; ++ks) {
                  const bf16x8 av = *(const LAS bf16x8*)(lds + L_KS + (16 * st + fr) * 272 + (ks * 32 + fq * 8) * 2);
                  const bf16x8 bv = *(const LAS bf16x8*)(lds + L_QS + (16 * tt + fr) * 272 + (ks * 32 + fq * 8) * 2);
                  a = __builtin_amdgcn_mfma_f32_16x16x32_bf16(av, bv, a, 0, 0, 0);
              }
              const int t = 16 * tt + fr, s0 = 16 * st + 4 * fq;
              float m[4];
#pragma unroll
              for (int i = 0; i < 4; ++i) { const int s = s0 + i; const bool keep = d == 0 ? (s <= t) : (s >= t); m[i] = keep ? a[i] : 0.f; }
              u32x2 pk; pk[0] = cvt_pk_bf16(m[0], m[1]); pk[1] = cvt_pk_bf16(m[2], m[3]);
              *(LAS u32x2*)(lds + L_ATT + t * 144 + s0 * 2) = pk;
          } }
        __syncthreads();
#pragma unroll
        for (int ks = 0; ks < 2; ++ks) {
#pragma unroll
            for (int tt = 0; tt < 4; ++tt) {
                const bf16x8 bv = *(const LAS bf16x8*)(lds + L_ATT + (16 * tt + fr) * 144 + (ks * 32 + fq * 8) * 2);
#pragma unroll
                for (int et = 0; et < 2; ++et) o[et][tt] = __builtin_amdgcn_mfma_f32_16x16x32_bf16(vfr[ks][et], bv, o[et][tt], 0, 0, 0);
            }
        }
        const bf16_t* sb = KVT + ((size_t)(d * 8 + bh) * NSLOT + slot) * 32768;
#pragma unroll
        for (int ks = 0; ks < 4; ++ks) {
            bf16x8 av[2];
#pragma unroll
            for (int et = 0; et < 2; ++et) av[et] = *(const bf16x8*)(sb + (32 * wid + 16 * et + fr) * 128 + ks * 32 + fq * 8);
#pragma unroll
            for (int tt = 0; tt < 4; ++tt) {
                const bf16x8 bv = *(const LAS bf16x8*)(lds + L_QE + (16 * tt + fr) * 272 + (ks * 32 + fq * 8) * 2);
#pragma unroll
                for (int et = 0; et < 2; ++et) o[et][tt] = __builtin_amdgcn_mfma_f32_16x16x32_bf16(av[et], bv, o[et][tt], 0, 0, 0);
            }
        }
        __syncthreads();
    }
    LAS float* red = (LAS float*)(lds + L_RED);
#pragma unroll
    for (int tt = 0; tt < 4; ++tt) {
        float s = 0.f;
#pragma unroll
        for (int et = 0; et < 2; ++et)
#pragma unroll
            for (int i = 0; i < 4; ++i) s += o[et][tt][i] * o[et][tt][i];
        s += __shfl_xor(s, 16, 64); s += __shfl_xor(s, 32, 64);
        if (fq == 0) red[wid * 64 + 16 * tt + fr] = s;
    }
    __syncthreads();
#pragma unroll
    for (int tt = 0; tt < 4; ++tt) {
        const int t = 16 * tt + fr;
        float tot = 0.f;
#pragma unroll
        for (int w = 0; w < 8; ++w) tot += red[w * 64 + t];
        const float rs = rsqrtf(tot * (1.f / 256.f) + 1e-5f);
#pragma unroll
        for (int et = 0; et < 2; ++et) {
            const int e = 32 * wid + 16 * et + 4 * fq;
            const f32x4 gn = *(const f32x4*)(p.gla_norm + e);
            const u32x2 gv = *(const u32x2*)(PX + (size_t)(row0 + t) * PXW + 2048 + h * 256 + e);
            const float g0 = bf_lo(gv[0]), g1 = bf_hi(gv[0]), g2 = bf_lo(gv[1]), g3 = bf_hi(gv[1]);
            const float v0 = o[et][tt][0] * rs * gn[0] * silu_f(g0), v1 = o[et][tt][1] * rs * gn[1] * silu_f(g1);
            const float v2 = o[et][tt][2] * rs * gn[2] * silu_f(g2), v3 = o[et][tt][3] * rs * gn[3] * silu_f(g3);
            u32x2 pk; pk[0] = cvt_pk_bf16(v0, v1); pk[1] = cvt_pk_bf16(v2, v3);
            if (DBG_ZERO_GLA) { pk[0] = 0; pk[1] = 0; }
            *(u32x2*)(OCAT + (size_t)(row0 + t) * D + h * 256 + e) = pk;
        }
    }
}
__device__ __forceinline__ void phase_gla_c(const Params& p, LAS unsigned char* lds) {
    for (int it = blockIdx.x; it < 512; it += gridDim.x) { gla_c_item(p, lds, it); __syncthreads(); }
}

__device__ __forceinline__ void run_gemm_gate(const Params& p, LAS unsigned char* lds, bool first) {
    unsigned char* ws = p.ws;
    Gemm g; g.A = (const bf16_t*)(ws + WS_ACT); g.Bt = (const bf16_t*)(ws + (first ? WS_WT1 : WS_WT5)); g.M = first ? MT : TL; g.N = NFF; g.K = D;
    Order S; S.init(g.M / BM, NFF / BM, gridDim.x, blockIdx.x, 0, D / BK);
    EpiGate E; E.H = (bf16_t*)(ws + WS_HID);
    gemm_phase(lds, g, S, E);
}
template <int WHICH>
__device__ __forceinline__ void run_gemm_resid(const Params& p, LAS unsigned char* lds) {
    constexpr int which = WHICH;
    unsigned char* ws = p.ws;
    float* H1 = (float*)(ws + WS_H1);
    Gemm g; EpiResid<(WHICH == 2 ? 2 : 1)> E; E.mod = (const float*)(ws + WS_MOD); E.out = H1; E.part = (float*)(ws + WS_PART);
    E.st.xbuf = (unsigned*)(ws + WS_XB); E.st.cnt = (unsigned*)(ws + WS_CNT) + which * 32 * 64; E.gain = which == 2 ? p.norm_final : (which == 1 ? p.norm_ffn2 : p.norm_mix); E.sh_idx = which == 0 ? 3 : 6; E.sc_idx = which == 0 ? 4 : 7; E.act = (bf16_t*)(ws + WS_ACT); E.fout = p.out;
    if (which == 0) { g.A = (const bf16_t*)(ws + WS_HID); g.Bt = (const bf16_t*)(ws + WS_WT2); g.M = TL; g.K = DFF; E.resid_lat = p.x; E.resid_ctx = p.ctx; E.gidx = 2; E.gs = 0.5f; }
    else if (which == 1) { g.A = (const bf16_t*)(ws + WS_ACT); g.Bt = (const bf16_t*)(ws + WS_WT4); g.M = TL; g.K = D; E.resid_lat = H1; E.resid_ctx = H1; E.gidx = 5; E.gs = 1.0f; }
    else { g.A = (const bf16_t*)(ws + WS_HID); g.Bt = (const bf16_t*)(ws + WS_WT6); g.M = TL; g.K = DFF; E.resid_lat = H1; E.resid_ctx = H1; E.gidx = 8; E.gs = 0.5f; }
    g.N = D;
    Order S; S.init(g.M / BM, D / BM, gridDim.x, blockIdx.x, which == 0 ? 2 : 0, g.K / BK);
    gemm_phase(lds, g, S, E);
}
__device__ __forceinline__ void run_gemm_in(const Params& p, LAS unsigned char* lds) {
    unsigned char* ws = p.ws;
    Gemm g; g.A = (const bf16_t*)(ws + WS_ACT); g.Bt = (const bf16_t*)(ws + WS_WT3); g.M = TL; g.N = N3; g.K = D;
    Order S; S.init(TL / BM, N3 / BM, gridDim.x, blockIdx.x, 1, D / BK);
    EpiIn E; E.PX = (bf16_t*)(ws + WS_PX); E.U = (bf16_t*)(ws + WS_U); E.GK = (float*)(ws + WS_GK);
    gemm_phase(lds, g, S, E);
}


#define XB_TMO      128
#define XB_XCNT(j)  (256  + 64 * (j))
#define XB_XSUB(j)  (1280 + 64 * (j))
#define XB_XGEN(j)  (2304 + 64 * (j))
#define XB_TOP      3328
#define XB_TOPGEN   3392
#define XCD_BAR_WORDS 3456
#define XB_SPIN_CAP (1u << 18)
__device__ __forceinline__ unsigned xb_ld(unsigned* p)              { return __hip_atomic_load(p, __ATOMIC_RELAXED, __HIP_MEMORY_SCOPE_AGENT); }
__device__ __forceinline__ unsigned xb_add(unsigned* p, unsigned v) { return __hip_atomic_fetch_add(p, v, __ATOMIC_RELAXED, __HIP_MEMORY_SCOPE_AGENT); }
__device__ __forceinline__ unsigned xb_xcc_id() { return (unsigned)__builtin_amdgcn_s_getreg((3 << 11) | 20) & 0xFu; }
#define XB_SPIN(cond, bar) do { unsigned _sp = 0; while (cond) { __builtin_amdgcn_s_sleep(1); \
    if ((++_sp & 255u) == 0u) { if (xb_ld(&(bar)[XB_TMO])) break; if (_sp > XB_SPIN_CAP) { atomicAdd(&(bar)[XB_TMO], 1u); break; } } } } while (0)
struct XcdBarrier { unsigned* bar; unsigned x; volatile LAS unsigned* st; };
__device__ __forceinline__ XcdBarrier xcd_barrier_post(unsigned* bar, volatile LAS unsigned* st) {
    XcdBarrier b; b.bar = bar; b.x = xb_xcc_id(); b.st = st;
    if (threadIdx.x == 0) (void)xb_add(&bar[XB_XCNT(b.x)], 1u);
    return b;
}
__device__ __forceinline__ void xcd_barrier_complete(unsigned* bar, unsigned x, unsigned& nloc, unsigned& nx) {
    const unsigned G = gridDim.x * gridDim.y * gridDim.z;
    unsigned sum, cnt, mine, sp = 0u;
    for (;;) {
        sum = 0u; cnt = 0u; mine = 0u;
#pragma unroll
        for (unsigned j = 0; j < 16; ++j) { const unsigned c = xb_ld(&bar[XB_XCNT(j)]); sum += c; cnt += (c > 0u) ? 1u : 0u; mine = (j == x) ? c : mine; }
        if (sum == G) break;
        __builtin_amdgcn_s_sleep(1);
        if ((++sp & 255u) == 0u) { if (xb_ld(&bar[XB_TMO])) break; if (sp > XB_SPIN_CAP) { atomicAdd(&bar[XB_TMO], 1u); break; } }
    }
    nloc = mine > 0u ? mine : 1u; nx = cnt > 0u ? cnt : 1u;
}
__device__ __forceinline__ void xcd_barrier(const XcdBarrier& b) {
    asm volatile("s_waitcnt vmcnt(0)" ::: "memory");
    __syncthreads();
    if (threadIdx.x == 0) {
        unsigned* bar = b.bar;
        __builtin_amdgcn_s_waitcnt(0);
        unsigned nloc = b.st[0], nx = b.st[1];
        if (nloc == 0u) { xcd_barrier_complete(bar, b.x, nloc, nx); b.st[0] = nloc; b.st[1] = nx; }
        const unsigned old = xb_add(&bar[XB_XSUB(b.x)], 1u);
        const unsigned gen = old / nloc;
        if (old + 1u == (gen + 1u) * nloc) {
            __builtin_amdgcn_fence(__ATOMIC_RELEASE, "agent");
            asm volatile("s_waitcnt vmcnt(0)" ::: "memory");
            const unsigned og = xb_add(&bar[XB_TOP], 1u);
            const unsigned tg = og / nx;
            if (og + 1u == (tg + 1u) * nx) xb_add(&bar[XB_TOPGEN], 1u);
            else XB_SPIN(xb_ld(&bar[XB_TOPGEN]) == tg, bar);
            __builtin_amdgcn_fence(__ATOMIC_ACQUIRE, "agent");
            xb_add(&bar[XB_XGEN(b.x)], 1u);
            asm volatile("s_waitcnt vmcnt(0)" ::: "memory");
        } else {
            XB_SPIN(xb_ld(&bar[XB_XGEN(b.x)]) == gen, bar);
            __builtin_amdgcn_fence(__ATOMIC_ACQUIRE, "agent");
            asm volatile("s_waitcnt vmcnt(0)" ::: "memory");
        }
    }
    __syncthreads();
}

__device__ __forceinline__ void grid_barrier(cg::grid_group& grid) {
    asm volatile("s_waitcnt vmcnt(0)" ::: "memory");
    __syncthreads();
    grid.sync();
    __builtin_amdgcn_fence(__ATOMIC_ACQUIRE, "agent");
    asm volatile("s_waitcnt vmcnt(0)" ::: "memory");
    __syncthreads();
}
#ifndef DBG_AFTER
#define DBG_AFTER -1
#endif
#ifndef DBG_OFF
#define DBG_OFF WS_HID
#endif
#ifndef DBG_F32
#define DBG_F32 0
#endif
__device__ __forceinline__ void dbg_dump(const Params& p) {
    const size_t n = (size_t)TL * D;
    for (size_t i = (size_t)blockIdx.x * 512 + threadIdx.x; i < n; i += (size_t)gridDim.x * 512) {
        float v;
        if (DBG_F32) v = ((const float*)(p.ws + DBG_OFF))[i]; else v = bf_lo(((const bf16_t*)(p.ws + DBG_OFF))[i]);
        if (!(fabsf(v) < 1e30f)) v = 777.f;
        p.out[i] = v;
    }
}
#define PHASE(n, body) do { if (ph_lo <= (n) && (n) < ph_hi) { if constexpr (((REP_MASK) >> (n)) & 1) { body; xcd_barrier(xb); } if constexpr (PH_ON(n)) { body; } if ((n) + 1 < ph_hi && (n) != 12) { if ((n) == 0) grid_barrier(grid); else xcd_barrier(xb); } if ((n) == DBG_AFTER) { dbg_dump(p); return; } } } while (0)
__global__ void __launch_bounds__(512, 2) mega(Params p, int ph_lo, int ph_hi) {
    extern __shared__ __attribute__((aligned(16))) unsigned char shm[];
    LAS unsigned char* lds = (LAS unsigned char*)shm;
    cg::grid_group grid = cg::this_grid();
    volatile LAS unsigned* xst = (volatile LAS unsigned*)(lds + LDS_BYTES - 16);
    if (threadIdx.x == 0) { xst[0] = 0u; xst[1] = 0u; }
    __syncthreads();
    if (blockIdx.x == 0) { unsigned* zw = (unsigned*)(p.ws + WS_BAR); for (int i = threadIdx.x; i < (int)(WS_ZERO_BYTES / 4); i += 512) zw[i] = 0u; }
    XcdBarrier xb; xb.bar = (unsigned*)(p.ws + WS_BAR); xb.x = xb_xcc_id(); xb.st = xst;
    PHASE(0, phase_prep_weights(p, lds));
    if (threadIdx.x == 0) (void)xb_add(&xb.bar[XB_XCNT(xb.x)], 1u);
    PHASE(1, phase_modnorm<0>(p, 0, MT, p.norm_ffn1, 0, 1));
    PHASE(2, (run_gemm_gate(p, lds, true), wconv_tail(p, lds, 34 * 44, 1408, 2112)));
    PHASE(3, run_gemm_resid<0>(p, lds));
    PHASE(4, phase_ctxnorm(p, lds));
    PHASE(5, (run_gemm_in(p, lds), wconv_tail(p, lds, 686, 2784, 4448)));
    PHASE(6, phase_gla_a_conv(p, lds));
    PHASE(7, phase_scan(p));
    PHASE(8, phase_gla_c(p, lds));
    PHASE(9, run_gemm_resid<1>(p, lds));
    PHASE(11, (run_gemm_gate(p, lds, false), wconv_tail(p, lds, 144, 4448, 5152)  , ((blockIdx.x >= 128 && blockIdx.x < 144) ? (gemv_item(p, lds, (int)blockIdx.x), __syncthreads()) : (void)0)));
    PHASE(12, run_gemm_resid<2>(p, lds));
}

extern "C" void kernel_launch(void* const* d_in, const int* in_sizes, int n_in, void* d_out, int out_size, void* d_ws, size_t ws_size, hipStream_t stream) {
    static int grid_blocks = 0;
    if (grid_blocks == 0) {
        if (ws_size < WS_END) { fprintf(stderr, "kernel_launch: workspace too small: %zu < %zu\n", ws_size, (size_t)WS_END); grid_blocks = -1; return; }
        int dev = 0, cus = 0, per_cu = 0;
        hipGetDevice(&dev);
        hipDeviceGetAttribute(&cus, hipDeviceAttributeMultiprocessorCount, dev);
        if (hipFuncSetAttribute((const void*)mega, hipFuncAttributeMaxDynamicSharedMemorySize, LDS_BYTES) != hipSuccess) { fprintf(stderr, "kernel_launch: hipFuncSetAttribute failed\n"); }
        if (hipOccupancyMaxActiveBlocksPerMultiprocessor(&per_cu, (const void*)mega, 512, LDS_BYTES) != hipSuccess || per_cu < 1) { fprintf(stderr, "kernel_launch: occupancy query gave %d\n", per_cu); per_cu = 1; }
        (void)hipGetLastError();
        if (per_cu > 1) per_cu = 1;
        grid_blocks = cus * per_cu;
        if (grid_blocks != 256) { fprintf(stderr, "kernel_launch: built for 256 workgroups (256 CUs x 1); got %d: nothing launched\n", grid_blocks); grid_blocks = -1; return; }
        fprintf(stderr, "kernel_launch: grid %d blocks (cus %d)\n", grid_blocks, cus);
    }
    if (grid_blocks < 0) return;
    Params p{};
    const float* const* in = (const float* const*)d_in;
    p.x = in[0]; p.c = in[1]; p.ctx = in[2]; p.c_ctx = in[3]; p.w_mod = in[4]; p.b_mod = in[5]; p.norm_ffn1 = in[6]; p.w_ffn1_in = in[7]; p.w_ffn1_out = in[8];
    p.norm_mix = in[9]; p.w_in = in[10]; p.w_gk2 = in[11]; p.b_gk2 = in[12]; p.gla_norm = in[13]; p.conv_w = in[14]; p.conv_b = in[15]; p.conv_ln_g = in[16];
    p.conv_ln_b = in[17]; p.w_out = in[18]; p.norm_ffn2 = in[19]; p.w_ffn2_in = in[20]; p.w_ffn2_out = in[21]; p.norm_final = in[22];
    p.out = (float*)d_out; p.ws = (unsigned char*)d_ws;
    int ph_lo = 0, ph_hi = NPHASE;
    void* args[] = {&p, &ph_lo, &ph_hi};
    hipError_t e = hipLaunchCooperativeKernel((const void*)mega, dim3(grid_blocks), dim3(512), args, LDS_BYTES, stream);
    if (e != hipSuccess) fprintf(stderr, "kernel_launch: cooperative launch failed: %s (grid %d)\n", hipGetErrorString(e), grid_blocks);
}
```
